# Optimizing an MI355X kernel written in HIP

```python
import math
import jax
import jax.numpy as jnp
from jax import lax
import numpy as np

D_MODEL = 2048
BATCH = 1
SEQ = 8192
DEPTH = 1

GRID_W = 64
CTX_LEN = 256
EPS = 1e-6

ML_HEADS = 8
ML_DQK = D_MODEL // 16
ML_DV = D_MODEL // 8
ML_QK_W = ML_HEADS * ML_DQK
ML_V_W = ML_HEADS * ML_DV
ML_CHUNK = 64

HY_W = D_MODEL
HY_ORDER = 2
HY_SHORT = 3
HY_BANDS = 8
HY_FEAT = 1 + 2 * HY_BANDS
HY_FFN = 64
HY_SHIFT = 0.05
HY_MIN_DECAY = math.log(1e-2) / 1.5
HY_MAX_DECAY = math.log(1e-2) / 0.3

PEER_HEADS = 8
PEER_NKEYS = 128
PEER_N = PEER_NKEYS * PEER_NKEYS
PEER_DKEY = 256
PEER_TOPK = 16
PEER_BLOCK = 128

IN_W = 2 * ML_QK_W + 2 * ML_V_W + 4 * ML_HEADS + 3 * HY_W + 2 * D_MODEL
IN_SPLIT = (2 * ML_QK_W,
            2 * ML_QK_W + ML_V_W,
            2 * ML_QK_W + 2 * ML_V_W,
            2 * ML_QK_W + 2 * ML_V_W + 4 * ML_HEADS,
            2 * ML_QK_W + 2 * ML_V_W + 4 * ML_HEADS + 3 * HY_W)

kernel_name = 'hybrid_mlstm_hyena_peer_flow_block'


def rmsnorm(x, g):
    xf = x.astype(jnp.float32)
    y = xf * lax.rsqrt(jnp.mean(xf * xf, axis=-1, keepdims=True) + EPS)
    return y.astype(x.dtype) * g


def dwconv1d(x, w):
    K = w.shape[0]
    L = x.shape[1]
    pad = K // 2
    xp = jnp.pad(x, ((0, 0), (pad, pad), (0, 0)))
    y = xp[:, 0:L] * w[0]
    for j in range(1, K):
        y = y + xp[:, j:j + L] * w[j]
    return y


def dwconv_grid(x, w, rows):
    B, L, C = x.shape
    img = x.reshape(B, rows, GRID_W, C)
    y = lax.conv_general_dilated(img, w[:, :, None, :], (1, 1), 'SAME',
                                 dimension_numbers=('NHWC', 'HWIO', 'NHWC'),
                                 feature_group_count=C)
    return y.reshape(B, L, C)


def _flip(a):
    return jnp.flip(a, axis=2)


def mlstm_heads(qk, v, gates, gate_b):
    B, L, _ = v.shape
    q, k = jnp.split(qk, 2, axis=-1)
    q = q.reshape(B, L, ML_HEADS, ML_DQK).transpose(0, 2, 1, 3).astype(jnp.float32) * (ML_DQK ** -0.5)
    k = k.reshape(B, L, ML_HEADS, ML_DQK).transpose(0, 2, 1, 3).astype(jnp.float32)
    vh = v.reshape(B, L, ML_HEADS, ML_DV).transpose(0, 2, 1, 3).astype(jnp.float32)
    g = gates.astype(jnp.float32).reshape(B, L, 4, ML_HEADS).transpose(2, 0, 3, 1) \
        + gate_b.astype(jnp.float32)[:, None, :, None]
    g_fwd = (g[0], jax.nn.log_sigmoid(g[1]))
    g_bwd = (g[2], jax.nn.log_sigmoid(g[3]))
    return q, k, vh, g_fwd, g_bwd


def mlstm_zero_state(B):
    return (jnp.zeros((B, ML_HEADS, ML_DQK, ML_DV), jnp.float32),
            jnp.zeros((B, ML_HEADS, ML_DQK), jnp.float32),
            jnp.zeros((B, ML_HEADS), jnp.float32))


def mlstm_final_state(k, v, log_i, log_f):
    b = jnp.cumsum(log_f, axis=-1)
    dec = b[..., -1:] - b + log_i
    m = jnp.max(dec, axis=-1)
    w = jnp.exp(dec - m[..., None])
    C = jnp.einsum('bhs,bhsd,bhsv->bhdv', w, k, v)
    n = jnp.einsum('bhs,bhsd->bhd', w, k)
    return (C, n, m)


def mlstm_chunkwise(q, k, v, log_i, log_f, state):
    B, H, L, _ = q.shape
    T = ML_CHUNK
    nc = L // T

    def to_chunks(a):
        return jnp.moveaxis(a.reshape(a.shape[:2] + (nc, T) + a.shape[3:]), 2, 0)

    causal = jnp.tril(jnp.ones((T, T), dtype=bool))

    def step(carry, inp):
        C, n, m = carry
        qb, kb, vb, ib, fb = inp
        b = jnp.cumsum(fb, axis=-1)
        D = b[..., :, None] - b[..., None, :] + ib[..., None, :]
        D = jnp.where(causal, D, -jnp.inf)
        inter = b + m[..., None]
        m_t = jnp.maximum(inter, jnp.max(D, axis=-1))
        w = jnp.exp(D - m_t[..., None])
        s_inter = jnp.exp(inter - m_t)
        qk = jnp.einsum('bhtd,bhsd->bhts', qb, kb) * w
        num = jnp.einsum('bhts,bhsv->bhtv', qk, vb) \
            + s_inter[..., None] * jnp.einsum('bhtd,bhdv->bhtv', qb, C)
        den = jnp.sum(qk, axis=-1) + s_inter * jnp.einsum('bhtd,bhd->bht', qb, n)
        h = num / jnp.maximum(jnp.abs(den), jnp.exp(-m_t))[..., None]
        bT = b[..., -1]
        dec = bT[..., None] - b + ib
        m_new = jnp.maximum(bT + m, jnp.max(dec, axis=-1))
        wk = jnp.exp(dec - m_new[..., None])
        s_old = jnp.exp(bT + m - m_new)
        C_new = s_old[..., None, None] * C + jnp.einsum('bhs,bhsd,bhsv->bhdv', wk, kb, vb)
        n_new = s_old[..., None] * n + jnp.einsum('bhs,bhsd->bhd', wk, kb)
        return (C_new, n_new, m_new), h

    _, h = lax.scan(step, state, (to_chunks(q), to_chunks(k), to_chunks(v),
                                  to_chunks(log_i), to_chunks(log_f)))
    return jnp.moveaxis(h, 0, 2).reshape(B, H, L, v.shape[-1])


def mlstm_bidir(q, k, v, g_fwd, g_bwd, st_f, st_b):
    h_f = mlstm_chunkwise(q, k, v, g_fwd[0], g_fwd[1], st_f)
    h_b = mlstm_chunkwise(_flip(q), _flip(k), _flip(v), _flip(g_bwd[0]), _flip(g_bwd[1]), st_b)
    return h_f + _flip(h_b)


def mlstm_out(h, o, g):
    B, H, L, dv = h.shape
    h = h * lax.rsqrt(jnp.mean(h * h, axis=-1, keepdims=True) + EPS)
    h = h.transpose(0, 2, 1, 3).reshape(B, L, H * dv).astype(o.dtype)
    return h * g * jax.nn.sigmoid(o)


def hyena_filters(L, w1, b1, w2, b2, w3, freq):
    t = jnp.arange(L, dtype=jnp.float32)
    tn = t / L
    bands = jnp.linspace(1e-4, HY_BANDS - 1, HY_BANDS, dtype=jnp.float32)
    ang = (2.0 * math.pi / L) * t[:, None] * bands[None, :]
    feats = jnp.concatenate([tn[:, None], jnp.cos(ang), -jnp.sin(ang)], axis=-1)
    hdn = jnp.sin(freq * (feats @ w1 + b1))
    hdn = jnp.sin(freq * (hdn @ w2 + b2))
    filt = (hdn @ w3).astype(jnp.float32).reshape(L, 2, HY_ORDER, HY_W)
    deltas = jnp.abs(jnp.linspace(HY_MIN_DECAY, HY_MAX_DECAY, HY_W, dtype=jnp.float32))
    window = jnp.exp(-tn[:, None] * deltas[None, :]) + HY_SHIFT
    return filt * window[:, None, None, :]


def long_conv(z, h_fwd, h_bwd, bias):
    L = z.shape[1]
    n = 2 * L
    Z = jnp.fft.rfft(z.astype(jnp.float32), n=n, axis=1)
    Hf = jnp.fft.rfft(h_fwd, n=n, axis=0)
    Hb = jnp.fft.rfft(h_bwd, n=n, axis=0)
    y = jnp.fft.irfft(Z * (Hf + jnp.conj(Hb))[None], n=n, axis=1)[:, :L]
    return (y + z.astype(jnp.float32) * bias.astype(jnp.float32)).astype(z.dtype)


def hyena(xs, filt, bias):
    x1, x2, z = jnp.split(xs, 3, axis=-1)
    z = x1 * long_conv(z, filt[:, 0, 0], filt[:, 1, 0], bias[0])
    z = x2 * long_conv(z, filt[:, 0, 1], filt[:, 1, 1], bias[1])
    return z


def merge(h_ml, h_hy, bg, w_pm, w_ph, w_o):
    g_ml, g_hy = jnp.split(bg, 2, axis=-1)
    y = jax.nn.sigmoid(g_ml) * (h_ml @ w_pm) + jax.nn.sigmoid(g_hy) * (h_hy @ w_ph)
    return y @ w_o


def peer(u, w_q, sub_keys, expert_u, expert_v):
    B, L, D = u.shape
    blocks = u.reshape(B * L // PEER_BLOCK, PEER_BLOCK, D)

    def one_block(ub):
        q = (ub @ w_q).reshape(PEER_BLOCK, PEER_HEADS, 2, PEER_DKEY // 2)
        s = jnp.einsum('thpd,hpkd->thpk', q, sub_keys).astype(jnp.float32)
        s1, i1 = lax.top_k(s[:, :, 0], PEER_TOPK)
        s2, i2 = lax.top_k(s[:, :, 1], PEER_TOPK)
        cand = (s1[..., :, None] + s2[..., None, :]).reshape(PEER_BLOCK, PEER_HEADS, PEER_TOPK * PEER_TOPK)
        cand_idx = (i1[..., :, None] * PEER_NKEYS + i2[..., None, :]).reshape(PEER_BLOCK, PEER_HEADS, PEER_TOPK * PEER_TOPK)
        best, pos = lax.top_k(cand, PEER_TOPK)
        e = jnp.take_along_axis(cand_idx, pos, axis=-1)
        g = jax.nn.softmax(best, axis=-1).astype(ub.dtype)
        act = jax.nn.gelu(jnp.einsum('td,thkd->thk', ub, expert_u[e]), approximate=False) * g
        return jnp.einsum('thk,thkd->td', act, expert_v[e])

    return lax.map(one_block, blocks).reshape(B, L, D)


def setup_inputs(seed: int = 0) -> dict:
    key = jax.random.key(seed)
    ks = jax.random.split(key, 32)

    def nrm(k, shape, s):
        return jax.random.normal(k, shape, jnp.float32) * s

    ib = nrm(ks[10], (DEPTH, 2, ML_HEADS), 0.1)
    fb = 3.0 + nrm(ks[11], (DEPTH, 2, ML_HEADS), 0.5)
    ml_gate_b = jnp.stack([ib[:, 0], fb[:, 0], ib[:, 1], fb[:, 1]], axis=1)
    return {
        'x': nrm(ks[0], (BATCH, SEQ, D_MODEL), 1.0),
        'c': nrm(ks[1], (BATCH, D_MODEL), 1.0),
        'ctx': nrm(ks[2], (BATCH, CTX_LEN, D_MODEL), 1.0),
        'c_ctx': nrm(ks[3], (D_MODEL,), 1.0),
        'w_mod': nrm(ks[4], (DEPTH, D_MODEL, 6 * D_MODEL), 0.5 * D_MODEL ** -0.5),
        'b_mod': nrm(ks[5], (DEPTH, 6 * D_MODEL), 0.02),
        'norm1_g': 1.0 + nrm(ks[6], (DEPTH, D_MODEL), 0.02),
        'norm2_g': 1.0 + nrm(ks[7], (DEPTH, D_MODEL), 0.02),
        'final_g': 1.0 + nrm(ks[8], (D_MODEL,), 0.02),
        'w_in': nrm(ks[9], (DEPTH, D_MODEL, IN_W), D_MODEL ** -0.5),
        'ml_conv_w': nrm(ks[12], (DEPTH, 3, 3, 2 * ML_QK_W), 1.0 / 3.0),
        'ml_gate_b': ml_gate_b,
        'ml_norm_g': 1.0 + nrm(ks[13], (DEPTH, ML_V_W), 0.02),
        'hy_conv_w': nrm(ks[14], (DEPTH, HY_SHORT, 3 * HY_W), HY_SHORT ** -0.5),
        'hy_w1': nrm(ks[15], (DEPTH, HY_FEAT, HY_FFN), HY_FEAT ** -0.5),
        'hy_b1': nrm(ks[16], (DEPTH, HY_FFN), 0.02),
        'hy_w2': nrm(ks[17], (DEPTH, HY_FFN, HY_FFN), HY_FFN ** -0.5),
        'hy_b2': nrm(ks[18], (DEPTH, HY_FFN), 0.02),
        'hy_w3': nrm(ks[19], (DEPTH, HY_FFN, 2 * HY_ORDER * HY_W), 0.05 * HY_FFN ** -0.5),
        'hy_freq': 1.0 + nrm(ks[20], (DEPTH, HY_FFN), 0.1),
        'hy_bias': nrm(ks[21], (DEPTH, HY_ORDER, HY_W), 0.5),
        'w_proj_ml': nrm(ks[22], (DEPTH, ML_V_W, D_MODEL), ML_V_W ** -0.5),
        'w_proj_hy': nrm(ks[23], (DEPTH, HY_W, D_MODEL), HY_W ** -0.5),
        'w_out': nrm(ks[24], (DEPTH, D_MODEL, D_MODEL), D_MODEL ** -0.5),
        'peer_wq': nrm(ks[25], (DEPTH, D_MODEL, PEER_HEADS * PEER_DKEY), D_MODEL ** -0.5),
        'peer_keys': nrm(ks[26], (DEPTH, PEER_HEADS, 2, PEER_NKEYS, PEER_DKEY // 2), (PEER_DKEY // 2) ** -0.5),
        'peer_u': nrm(ks[27], (DEPTH, PEER_N, D_MODEL), D_MODEL ** -0.5),
        'peer_v': nrm(ks[28], (DEPTH, PEER_N, D_MODEL), 0.5),
    }


def reference(x, c, ctx, c_ctx, w_mod, b_mod, norm1_g, norm2_g, final_g, w_in, ml_conv_w,
              ml_gate_b, ml_norm_g, hy_conv_w, hy_w1, hy_b1, hy_w2, hy_b2, hy_w3, hy_freq,
              hy_bias, w_proj_ml, w_proj_hy, w_out, peer_wq, peer_keys, peer_u, peer_v):
    B, L, D = x.shape
    rows = L // GRID_W
    L_ctx = ctx.shape[1]
    s_lat = jax.nn.silu(c)[:, None, :]
    s_ctx = jax.nn.silu(c_ctx)
    h_lat, h_ctx = x, ctx
    for l in range(DEPTH):
        last = l == DEPTH - 1
        sh1, sc1, g1, sh2, sc2, g2 = jnp.split(s_lat @ w_mod[l] + b_mod[l], 6, axis=-1)
        csh1, csc1, cg1, csh2, csc2, cg2 = jnp.split(s_ctx @ w_mod[l] + b_mod[l], 6, axis=-1)

        u_lat = rmsnorm(h_lat, norm1_g[l]) * (1.0 + sc1) + sh1
        u_ctx = rmsnorm(h_ctx, norm1_g[l]) * (1.0 + csc1) + csh1
        qk_l, v_l, o_l, gt_l, hy_l, bg_l = jnp.split(u_lat @ w_in[l], IN_SPLIT, axis=-1)
        qk_c, v_c, o_c, gt_c, hy_c, bg_c = jnp.split(u_ctx @ w_in[l], IN_SPLIT, axis=-1)

        qk_l = jax.nn.silu(dwconv_grid(qk_l, ml_conv_w[l], rows))
        qk_c = jax.nn.silu(dwconv1d(qk_c, ml_conv_w[l][1]))
        q_l, k_l, vh_l, gf_l, gb_l = mlstm_heads(qk_l, v_l, gt_l, ml_gate_b[l])
        q_c, k_c, vh_c, gf_c, gb_c = mlstm_heads(qk_c, v_c, gt_c, ml_gate_b[l])
        st_f = mlstm_final_state(k_c, vh_c, gf_c[0], gf_c[1])
        st_b = mlstm_final_state(_flip(k_c), _flip(vh_c), _flip(gb_c[0]), _flip(gb_c[1]))
        h_ml_l = mlstm_out(mlstm_bidir(q_l, k_l, vh_l, gf_l, gb_l, st_f, st_b), o_l, ml_norm_g[l])

        filt_l = hyena_filters(L, hy_w1[l], hy_b1[l], hy_w2[l], hy_b2[l], hy_w3[l], hy_freq[l])
        h_hy_l = hyena(dwconv1d(hy_l, hy_conv_w[l]), filt_l, hy_bias[l])
        mix_l = merge(h_ml_l, h_hy_l, bg_l, w_proj_ml[l], w_proj_hy[l], w_out[l])

        if not last:
            zero = mlstm_zero_state(B)
            h_ml_c = mlstm_out(mlstm_bidir(q_c, k_c, vh_c, gf_c, gb_c, zero, zero), o_c, ml_norm_g[l])
            filt_c = hyena_filters(L_ctx, hy_w1[l], hy_b1[l], hy_w2[l], hy_b2[l], hy_w3[l], hy_freq[l])
            h_hy_c = hyena(dwconv1d(hy_c, hy_conv_w[l]), filt_c, hy_bias[l])
            mix_c = merge(h_ml_c, h_hy_c, bg_c, w_proj_ml[l], w_proj_hy[l], w_out[l])

        h_lat = h_lat + g1 * mix_l

        v_lat = rmsnorm(h_lat, norm2_g[l]) * (1.0 + sc2) + sh2
        h_lat = h_lat + g2 * peer(v_lat, peer_wq[l], peer_keys[l], peer_u[l], peer_v[l])

        if not last:
            h_ctx = h_ctx + cg1 * mix_c
            v_ctx = rmsnorm(h_ctx, norm2_g[l]) * (1.0 + csc2) + csh2
            h_ctx = h_ctx + cg2 * peer(v_ctx, peer_wq[l], peer_keys[l], peer_u[l], peer_v[l])

    return rmsnorm(h_lat, final_g)
```

```cpp
#include <hip/hip_runtime.h>
#include <hip/hip_cooperative_groups.h>
#include <cstdio>
#include <cstdint>
namespace cg = cooperative_groups;

namespace pg8 {
#define PG8_LAS __attribute__((address_space(3)))
typedef unsigned short bf16_t;
typedef short bf16x8 __attribute__((ext_vector_type(8)));
typedef float f32x4 __attribute__((ext_vector_type(4)));
typedef unsigned u32x4 __attribute__((ext_vector_type(4)));
typedef unsigned u32x2 __attribute__((ext_vector_type(2)));
constexpr int BM = 256, BK = 64, HALF = 128, HTB = HALF * BK * 2, STAGE_BYTES = 8 * HTB, NXCD = 8, WGM = 8;
__host__ __device__ __forceinline__ int lds_byte(int r, int c) { const int st = (r >> 4) * 2 + (c >> 5), rr = r & 15, cc = c & 31, ob = rr * 64 + cc * 2; return st * 1024 + (ob ^ (((ob >> 9) & 1) << 5)); }
__host__ __device__ __forceinline__ void stage_rc(int b, int& R, int& C) { const int st = b / 1024, sb = b % 1024, swz = sb ^ (((sb >> 9) & 1) << 5); R = (st >> 1) * 16 + swz / 64; C = (st & 1) * 32 + (swz % 64) / 2; }
__host__ __device__ __forceinline__ int perm32(int rho) { const int n = rho >> 4, i = rho & 15; return 8 * (i >> 2) + 4 * n + (i & 3); }

struct Unit { int pm, pn; };
struct Gemm { const bf16_t* A; const bf16_t* Bt; int M, N, K; };

struct StaticOrder {
    int nM, nN, nwg, G, c;
    __host__ __device__ void init(int M, int N, int G_, int c_) { nM = M / BM; nN = N / BM; nwg = nM * nN; G = G_; c = c_; }
    __host__ __device__ bool next(int i, Unit& u) const {
        const long L = (long)i * G + c; if (L >= nwg) return false;
        int wgid = (int)L; { const int q = nwg / NXCD, r = nwg % NXCD, xcd = wgid % NXCD, off = wgid / NXCD; wgid = (xcd < r ? xcd * (q + 1) : r * (q + 1) + (xcd - r) * q) + off; }
        const int nig = WGM * nN, gid = wgid / nig, fm = gid * WGM, gsz = (nM - fm) < WGM ? (nM - fm) : WGM;
        u.pm = fm + ((wgid % nig) % gsz); u.pn = (wgid % nig) / gsz; return true;
    }
    __device__ __forceinline__ void a_ready(const Unit&) const {}
    __device__ __forceinline__ void done(const Unit&) const {}
};
__device__ __forceinline__ unsigned cvt_pk_bf16(float lo, float hi) { unsigned r; asm volatile("v_cvt_pk_bf16_f32 %0, %1, %2" : "=v"(r) : "v"(lo), "v"(hi)); return r; }
__device__ __forceinline__ float bflo(unsigned w) { return __uint_as_float(w << 16); }
__device__ __forceinline__ float bfhi(unsigned w) { return __uint_as_float(w & 0xffff0000u); }
__device__ __forceinline__ float sigm(float x) { return 1.0f / (1.0f + __expf(-x)); }
struct EpiBf16 {
    static constexpr bool PERM = true, AFTER_DRAIN = false;
    bf16_t* O; int ldc;
    __device__ __forceinline__ void operator()(const f32x4 (&acc)[2][2][4][2], const Unit& u, int wr, int wc, int fr, int fq) const {
        const int row0 = u.pm * BM + wr * 64 + fr, col0 = u.pn * BM + wc * 32 + 8 * fq;
#pragma unroll
        for (int ai = 0; ai < 2; ++ai)
#pragma unroll
            for (int m = 0; m < 4; ++m) { bf16_t* rowp = O + (size_t)(row0 + ai * HALF + m * 16) * ldc + col0;
#pragma unroll
                for (int bj = 0; bj < 2; ++bj) { const f32x4 v0 = acc[ai][bj][m][0], v1 = acc[ai][bj][m][1];
                    u32x4 w; w.x = cvt_pk_bf16(v0[0], v0[1]); w.y = cvt_pk_bf16(v0[2], v0[3]); w.z = cvt_pk_bf16(v1[0], v1[1]); w.w = cvt_pk_bf16(v1[2], v1[3]);
                    *(u32x4*)(rowp + bj * HALF) = w; } }
    }
};
struct EpiGate1 {
    static constexpr bool PERM = false, AFTER_DRAIN = false;
    float* Y1; int ldc; const bf16_t* bg; int ldg;
    __device__ __forceinline__ void operator()(const f32x4 (&acc)[2][2][4][2], const Unit& u, int wr, int wc, int fr, int fq) const {
        const int row0 = u.pm * BM + wr * 64 + fr, col0 = u.pn * BM + wc * 32 + 4 * fq;
#pragma unroll
        for (int ai = 0; ai < 2; ++ai)
#pragma unroll
            for (int m = 0; m < 4; ++m) { const size_t r = (size_t)(row0 + ai * HALF + m * 16);
#pragma unroll
                for (int bj = 0; bj < 2; ++bj)
#pragma unroll
                    for (int n = 0; n < 2; ++n) { const int c = col0 + bj * HALF + n * 16; const u32x2 gw = *(const u32x2*)(bg + r * ldg + c); const f32x4 a = acc[ai][bj][m][n];
                        f32x4 o; o[0] = sigm(bflo(gw.x)) * a[0]; o[1] = sigm(bfhi(gw.x)) * a[1]; o[2] = sigm(bflo(gw.y)) * a[2]; o[3] = sigm(bfhi(gw.y)) * a[3];
                        *(f32x4*)(Y1 + r * ldc + c) = o; } }
    }
};
struct EpiGate2 {
    static constexpr bool PERM = false, AFTER_DRAIN = false;
    const float* Y1; bf16_t* Y; int ldc; const bf16_t* bg; int ldg;
    __device__ __forceinline__ void operator()(const f32x4 (&acc)[2][2][4][2], const Unit& u, int wr, int wc, int fr, int fq) const {
        const int row0 = u.pm * BM + wr * 64 + fr, col0 = u.pn * BM + wc * 32 + 4 * fq;
#pragma unroll
        for (int ai = 0; ai < 2; ++ai)
#pragma unroll
            for (int m = 0; m < 4; ++m) { const size_t r = (size_t)(row0 + ai * HALF + m * 16);
#pragma unroll
                for (int bj = 0; bj < 2; ++bj)
#pragma unroll
                    for (int n = 0; n < 2; ++n) { const int c = col0 + bj * HALF + n * 16; const u32x2 gw = *(const u32x2*)(bg + r * ldg + c); const f32x4 a = acc[ai][bj][m][n];
                        const f32x4 y1 = *(const f32x4*)(Y1 + r * ldc + c);
                        u32x2 w; w.x = cvt_pk_bf16(y1[0] + sigm(bflo(gw.x)) * a[0], y1[1] + sigm(bfhi(gw.x)) * a[1]); w.y = cvt_pk_bf16(y1[2] + sigm(bflo(gw.y)) * a[2], y1[3] + sigm(bfhi(gw.y)) * a[3]);
                        *(u32x2*)(Y + r * ldc + c) = w; } }
    }
};
struct EpiRes {
    static constexpr bool PERM = false, AFTER_DRAIN = false;
    const float* X; float* H; int ldc; const float* g1;
    __device__ __forceinline__ void operator()(const f32x4 (&acc)[2][2][4][2], const Unit& u, int wr, int wc, int fr, int fq) const {
        const int row0 = u.pm * BM + wr * 64 + fr, col0 = u.pn * BM + wc * 32 + 4 * fq;
#pragma unroll
        for (int ai = 0; ai < 2; ++ai)
#pragma unroll
            for (int m = 0; m < 4; ++m) { const size_t r = (size_t)(row0 + ai * HALF + m * 16);
#pragma unroll
                for (int bj = 0; bj < 2; ++bj)
#pragma unroll
                    for (int n = 0; n < 2; ++n) { const int c = col0 + bj * HALF + n * 16; const f32x4 gv = *(const f32x4*)(g1 + c); const f32x4 xv = *(const f32x4*)(X + r * ldc + c);
                        *(f32x4*)(H + r * ldc + c) = xv + gv * acc[ai][bj][m][n]; } }
    }
};
template <class Epi, class Sched>
__device__ __forceinline__ void gemm_phase(PG8_LAS unsigned char* lds, const Gemm g, const Sched& S, const Epi& E) {
    const int tid = threadIdx.x, wid = __builtin_amdgcn_readfirstlane(tid >> 6), lane = tid & 63, wr = wid >> 2, wc = wid & 3, fr = lane & 15, fq = lane >> 4;
    const int K = g.K, nt = K / BK;
    unsigned voffA[2], voffB[2];
#pragma unroll
    for (int i = 0; i < 2; ++i) { int R, C; stage_rc(tid * 16 + i * 8192, R, C); const int Rb = Epi::PERM ? ((R & ~31) + perm32(R & 31)) : R;
        voffA[i] = (unsigned)(R * K + C) * 2u; voffB[i] = (unsigned)(Rb * K + C) * 2u; }
    const size_t kstep = (size_t)(BK * 2);
    const size_t hstep = (size_t)HALF * K * 2;
    const size_t tstep = 2 * hstep;
    const unsigned ldsw = (unsigned)wid * 1024u;
    const int aoff = lds_byte(wr * 64 + fr, fq * 8), boff = lds_byte(wc * 32 + fr, fq * 8);
#define PG8_SA(b, h) (((b) * 2 + (h)) * HTB)
#define PG8_SB(b, h) ((4 + (b) * 2 + (h)) * HTB)
#define PG8_STAGE(bufoff, gbase, voff) do { _Pragma("unroll") for (int _i = 0; _i < 2; ++_i) \
        __builtin_amdgcn_global_load_lds((const unsigned*)((const char*)(gbase) + (voff)[_i]), (PG8_LAS unsigned*)(lds + (bufoff) + ldsw + _i * 8192), 16, 0, 0); } while (0)
#define PG8_LDA(dst, b, h) do { _Pragma("unroll") for (int m = 0; m < 4; ++m) _Pragma("unroll") for (int k = 0; k < 2; ++k) dst[m][k] = *(const PG8_LAS bf16x8*)(lds + PG8_SA(b, h) + aoff + m * 2048 + k * 1024); } while (0)
#define PG8_LDB(dst, b, h) do { _Pragma("unroll") for (int n = 0; n < 2; ++n) _Pragma("unroll") for (int k = 0; k < 2; ++k) dst[n][k] = *(const PG8_LAS bf16x8*)(lds + PG8_SB(b, h) + boff + n * 2048 + k * 1024); } while (0)
#define PG8_MMA(ai, bj, At, Bt) do { __builtin_amdgcn_s_setprio(1); _Pragma("unroll") for (int m = 0; m < 4; ++m) _Pragma("unroll") for (int n = 0; n < 2; ++n) _Pragma("unroll") for (int k = 0; k < 2; ++k) \
        acc[ai][bj][m][n] = __builtin_amdgcn_mfma_f32_16x16x32_bf16(Bt[n][k], At[m][k], acc[ai][bj][m][n], 0, 0, 0); __builtin_amdgcn_s_setprio(0); } while (0)
#define PG8_WAIT_V(n) asm volatile("s_waitcnt vmcnt(" #n ")" ::: "memory")
#define PG8_WAIT_L(n) asm volatile("s_waitcnt lgkmcnt(" #n ")" ::: "memory")
#define PG8_BAR __builtin_amdgcn_s_barrier()
#define PG8_SCHED __builtin_amdgcn_sched_barrier(0)
    Unit cur, nxt; int ui = 0;
    if (!S.next(0, cur)) return;
    f32x4 acc[2][2][4][2];
#pragma unroll
    for (int a = 0; a < 2; ++a)
#pragma unroll
        for (int b = 0; b < 2; ++b)
#pragma unroll
            for (int m = 0; m < 4; ++m)
#pragma unroll
                for (int n = 0; n < 2; ++n) acc[a][b][m][n] = (f32x4){0.f, 0.f, 0.f, 0.f};
    bf16x8 At[4][2], B0[2][2], B1[2][2];
    const char* cA = (const char*)g.A + (size_t)cur.pm * tstep; const char* cB = (const char*)g.Bt + (size_t)cur.pn * tstep;
    S.a_ready(cur);
    PG8_STAGE(PG8_SB(0, 0), cB, voffB); PG8_STAGE(PG8_SA(0, 0), cA, voffA); PG8_STAGE(PG8_SB(0, 1), cB + hstep, voffB); PG8_STAGE(PG8_SA(0, 1), cA + hstep, voffA);
    if (wr == 1) PG8_BAR;
    PG8_WAIT_V(4); PG8_BAR;
    PG8_STAGE(PG8_SB(1, 0), cB + kstep, voffB); PG8_STAGE(PG8_SA(1, 0), cA + kstep, voffA); PG8_STAGE(PG8_SB(1, 1), cB + hstep + kstep, voffB);
    PG8_WAIT_V(6); PG8_BAR;
    for (;;) {
        const bool has_next = S.next(ui + 1, nxt);
        const char* nA = has_next ? (const char*)g.A + (size_t)nxt.pm * tstep : cA; const char* nB = has_next ? (const char*)g.Bt + (size_t)nxt.pn * tstep : cB;
        for (int t = 0; t < nt; t += 2) {
            const bool last = (t == nt - 2);
            const char* a1 = cA + (size_t)(t + 1) * kstep;
            const char* a2 = last ? nA : cA + (size_t)(t + 2) * kstep; const char* b2 = last ? nB : cB + (size_t)(t + 2) * kstep;
            const char* a3 = a2 + kstep; const char* b3 = b2 + kstep;
            if (last && has_next) S.a_ready(nxt);
            PG8_LDB(B0, 0, 0); PG8_SCHED; PG8_LDA(At, 0, 0); PG8_STAGE(PG8_SA(1, 1), a1 + hstep, voffA);
            PG8_WAIT_L(8); PG8_BAR; PG8_WAIT_L(0); PG8_MMA(0, 0, At, B0); PG8_BAR; PG8_SCHED;
            PG8_LDB(B1, 0, 1); PG8_STAGE(PG8_SB(0, 0), b2, voffB);
            PG8_BAR; PG8_WAIT_L(0); PG8_MMA(0, 1, At, B1); PG8_BAR;
            PG8_LDA(At, 0, 1); PG8_STAGE(PG8_SA(0, 0), a2, voffA);
            PG8_BAR; PG8_WAIT_L(0); PG8_MMA(1, 0, At, B0); PG8_BAR; PG8_SCHED;
            PG8_STAGE(PG8_SB(0, 1), b2 + hstep, voffB);
            PG8_WAIT_V(6); PG8_BAR; PG8_MMA(1, 1, At, B1); PG8_BAR;
            PG8_LDB(B0, 1, 0); PG8_SCHED; PG8_LDA(At, 1, 0); PG8_STAGE(PG8_SA(0, 1), a2 + hstep, voffA);
            PG8_WAIT_L(8); PG8_BAR; PG8_WAIT_L(0); PG8_MMA(0, 0, At, B0); PG8_BAR; PG8_SCHED;
            PG8_LDB(B1, 1, 1); PG8_STAGE(PG8_SB(1, 0), b3, voffB);
            PG8_BAR; PG8_WAIT_L(0); PG8_MMA(0, 1, At, B1); PG8_BAR;
            PG8_LDA(At, 1, 1); PG8_STAGE(PG8_SA(1, 0), a3, voffA);
            PG8_BAR; PG8_WAIT_L(0); PG8_MMA(1, 0, At, B0); PG8_BAR; PG8_SCHED;
            PG8_STAGE(PG8_SB(1, 1), b3 + hstep, voffB);
            PG8_WAIT_V(6); PG8_BAR; PG8_MMA(1, 1, At, B1); PG8_BAR;
        }
        if constexpr (!Epi::AFTER_DRAIN) { E(acc, cur, wr, wc, fr, fq); S.done(cur); }
        if (!has_next) break;
#pragma unroll
        for (int a = 0; a < 2; ++a)
#pragma unroll
            for (int b = 0; b < 2; ++b)
#pragma unroll
                for (int m = 0; m < 4; ++m)
#pragma unroll
                    for (int n = 0; n < 2; ++n) acc[a][b][m][n] = (f32x4){0.f, 0.f, 0.f, 0.f};
        cur = nxt; cA = nA; cB = nB; ++ui;
    }
    PG8_WAIT_V(0);
    if (wr == 0) PG8_BAR;
    PG8_BAR;
    if constexpr (Epi::AFTER_DRAIN) { E.fused(acc, cur, wr, wc, fr, fq, lds, wid, lane); S.done(cur); }
#undef PG8_SA
#undef PG8_SB
#undef PG8_STAGE
#undef PG8_LDA
#undef PG8_LDB
#undef PG8_MMA
#undef PG8_WAIT_V
#undef PG8_WAIT_L
#undef PG8_BAR
#undef PG8_SCHED
}
}

#define XB_TMO      128
#define XB_XCNT(j)  (256  + 64 * (j))
#define XB_XSUB(j)  (1280 + 64 * (j))
#define XB_XGEN(j)  (2304 + 64 * (j))
#define XB_TOP      3328
#define XB_TOPGEN   3392
#define XCD_BAR_WORDS 3456
#define XB_SPIN_CAP (1u << 22)
#define LAS __attribute__((address_space(3)))
__device__ __forceinline__ unsigned xb_ld(unsigned* p)              { return __hip_atomic_load(p, __ATOMIC_RELAXED, __HIP_MEMORY_SCOPE_AGENT); }
__device__ __forceinline__ unsigned xb_add(unsigned* p, unsigned v) { return __hip_atomic_fetch_add(p, v, __ATOMIC_RELAXED, __HIP_MEMORY_SCOPE_AGENT); }
__device__ __forceinline__ unsigned xb_xcc_id() { return (unsigned)__builtin_amdgcn_s_getreg((3 << 11) | 20) & 0xFu; }
#define XB_SPIN(cond, bar) do { unsigned _sp = 0; while (cond) { __builtin_amdgcn_s_sleep(1); \
    if ((++_sp & 255u) == 0u) { if (xb_ld(&(bar)[XB_TMO])) break; if (_sp > XB_SPIN_CAP) { atomicAdd(&(bar)[XB_TMO], 1u); break; } } } } while (0)
struct XcdBarrier { unsigned* bar; unsigned x; volatile LAS unsigned* st; };
__device__ __forceinline__ XcdBarrier xcd_barrier_post(unsigned* bar, volatile LAS unsigned* st) {
    XcdBarrier b; b.bar = bar; b.x = xb_xcc_id(); b.st = st;
    if (threadIdx.x == 0) (void)xb_add(&bar[XB_XCNT(b.x)], 1u);
    return b;
}
__device__ __forceinline__ void xcd_barrier_complete(unsigned* bar, unsigned x, unsigned& nloc, unsigned& nx) {
    const unsigned G = gridDim.x * gridDim.y * gridDim.z;
    unsigned sum, cnt, mine, sp = 0u;
    for (;;) {
        sum = 0u; cnt = 0u; mine = 0u;
#pragma unroll
        for (unsigned j = 0; j < 16; ++j) { const unsigned c = xb_ld(&bar[XB_XCNT(j)]); sum += c; cnt += (c > 0u) ? 1u : 0u; mine = (j == x) ? c : mine; }
        if (sum == G) break;
        __builtin_amdgcn_s_sleep(1);
        if ((++sp & 255u) == 0u) { if (xb_ld(&bar[XB_TMO])) break; if (sp > XB_SPIN_CAP) { atomicAdd(&bar[XB_TMO], 1u); break; } }
    }
    nloc = mine > 0u ? mine : 1u; nx = cnt > 0u ? cnt : 1u;
}
__device__ __forceinline__ void xcd_barrier(const XcdBarrier& b) {
    asm volatile("s_waitcnt vmcnt(0)" ::: "memory");
    __syncthreads();
    if (threadIdx.x == 0) {
        unsigned* bar = b.bar;
        __builtin_amdgcn_s_waitcnt(0);
        unsigned nloc = b.st[0], nx = b.st[1];
        if (nloc == 0u) { xcd_barrier_complete(bar, b.x, nloc, nx); b.st[0] = nloc; b.st[1] = nx; }
        const unsigned old = xb_add(&bar[XB_XSUB(b.x)], 1u);
        const unsigned gen = old / nloc;
        if (old + 1u == (gen + 1u) * nloc) {
            __builtin_amdgcn_fence(__ATOMIC_RELEASE, "agent");
            asm volatile("s_waitcnt vmcnt(0)" ::: "memory");
            const unsigned og = xb_add(&bar[XB_TOP], 1u);
            const unsigned tg = og / nx;
            if (og + 1u == (tg + 1u) * nx) xb_add(&bar[XB_TOPGEN], 1u);
            else XB_SPIN(xb_ld(&bar[XB_TOPGEN]) == tg, bar);
            __builtin_amdgcn_fence(__ATOMIC_ACQUIRE, "agent");
            xb_add(&bar[XB_XGEN(b.x)], 1u);
            asm volatile("s_waitcnt vmcnt(0)" ::: "memory");
        } else {
            XB_SPIN(xb_ld(&bar[XB_XGEN(b.x)]) == gen, bar);
            __builtin_amdgcn_fence(__ATOMIC_ACQUIRE, "agent");
            asm volatile("s_waitcnt vmcnt(0)" ::: "memory");
        }
    }
    __syncthreads();
}

typedef unsigned short bf16_t;
typedef short bf16x8 __attribute__((ext_vector_type(8)));
typedef float f32x4 __attribute__((ext_vector_type(4)));
typedef unsigned u32x4 __attribute__((ext_vector_type(4)));
typedef unsigned u32x2 __attribute__((ext_vector_type(2)));
typedef short s16x4 __attribute__((ext_vector_type(4)));
constexpr int NT = 512;
constexpr int D = 2048, L = 8192, LC = 256, LT = L + LC;
constexpr int INW = 16416;
constexpr int NREST = 10496;
constexpr int C_QK = 0, C_V = 2048, C_O = 4096, C_BGM = 6144, C_BGH = 8192, C_GT = 10240;
constexpr int NCH = 16, NCK = 33, TC = 256;
constexpr float EPS = 1e-6f;
constexpr int LDS_MAIN = 144 * 1024;
constexpr int LDS_BYTES = LDS_MAIN + 16;
#ifndef REPEAT_MASK
#define REPEAT_MASK 0
#endif
constexpr int KS = 32;
#ifndef GXV
#define GXV 2
#endif
constexpr int GX = GXV;
static_assert(GX == 2 || GX == 1, "EX_COMPUTE evaluates the gelu of exactly two experts per group");

constexpr size_t al(size_t x) { return (x + 255) & ~(size_t)255; }
constexpr size_t WS_MODP = 0;
constexpr size_t WS_MOD = WS_MODP + al((size_t)KS * 2 * 12288 * 4);
constexpr size_t WS_HDN = WS_MOD + al((size_t)2 * 12288 * 4);
constexpr size_t WS_WPM = WS_HDN + al((size_t)L * 64 * 2);
constexpr size_t WS_WPH = WS_WPM + al((size_t)D * D * 2);
constexpr size_t WS_WO = WS_WPH + al((size_t)D * D * 2);
constexpr size_t WS_WQ = WS_WO + al((size_t)D * D * 2);
constexpr size_t WS_A = WS_WQ + al((size_t)D * D * 2);
constexpr size_t WS_WREST = WS_A;
constexpr size_t WS_WHY = WS_WREST + al((size_t)NREST * D * 2);
constexpr size_t WS_A_END = WS_WHY + al((size_t)6144 * D * 2);
constexpr size_t WS_HML = WS_A;
constexpr size_t WS_HYOT = WS_HML + al((size_t)L * D * 2);
static_assert(WS_HYOT + (size_t)L * D * 2 <= WS_A_END, "region A overlay");
constexpr size_t WS_U = WS_A_END;
constexpr size_t WS_U_END = WS_U + al((size_t)LT * D * 2);
constexpr size_t WS_SPRE = WS_U;
constexpr size_t WS_VL = WS_U;
static_assert((size_t)NCH * NCK * 256 * 128 * 2 <= WS_U_END - WS_U, "SPRE overlay");
constexpr size_t WS_P1 = WS_U_END;
constexpr size_t WS_P1_END = WS_P1 + al((size_t)LT * NREST * 2);
constexpr size_t WS_HYT = WS_P1_END;
constexpr size_t WS_HYT_END = WS_HYT + al((size_t)6144 * L * 2);
constexpr size_t WS_HLAT = WS_HYT;
static_assert((size_t)L * D * 4 <= WS_HYT_END - WS_HYT, "HLAT overlay");
constexpr size_t WS_QK = WS_HYT_END;
constexpr size_t WS_QP = WS_QK;
constexpr size_t WS_G = WS_QK + al((size_t)LT * D * 2);
constexpr size_t WS_GB = WS_G, WS_GA = WS_GB + al((size_t)NCH * LT * 4), WS_GM = WS_GA + al((size_t)NCH * LT * 4);
constexpr size_t WS_SLOC = WS_GM + al((size_t)NCH * LT * 4);
constexpr size_t WS_SLOC_END = WS_SLOC + al((size_t)NCH * NCK * 256 * 128 * 4);
constexpr size_t WS_Y1 = WS_SLOC;
constexpr size_t WS_NLOC = WS_SLOC_END;
constexpr size_t WS_NPRE = WS_NLOC + al((size_t)NCH * NCK * 128 * 4);
constexpr size_t WS_MLOC = WS_NPRE + al((size_t)NCH * NCK * 128 * 4);
constexpr size_t WS_MPRE = WS_MLOC + al((size_t)NCH * NCK * 4);
constexpr size_t WS_HYO = WS_MPRE + al((size_t)NCH * NCK * 4);
constexpr size_t WS_Y = WS_HYO + al((size_t)L * D * 2);
constexpr size_t WS_YEND = WS_Y + al((size_t)L * D * 2);
constexpr size_t WS_FILT = WS_SLOC;
static_assert(WS_FILT + (size_t)8192 * 8192 * 2 <= WS_YEND, "FILT overlay");
constexpr size_t WS_BAR = WS_YEND;
constexpr size_t WS_KEYB = WS_BAR + al((size_t)XCD_BAR_WORDS * 4);
constexpr size_t WS_PU = WS_KEYB + al((size_t)8 * 2 * 128 * 128 * 2);
constexpr size_t WS_PSU = WS_PU + al((size_t)16384 * D);
constexpr size_t WS_PSV = WS_PSU + al((size_t)16384 * 4);
constexpr size_t WS_END = WS_PSV + al((size_t)16384 * 4);
constexpr size_t WS_PV = WS_HYT + al((size_t)L * D * 4);
static_assert(WS_PV + (size_t)16384 * D <= WS_HYT_END, "V table tail overlay");
static_assert(WS_END <= (size_t)643323008, "workspace map must stay within sum(inputs) bytes, the guaranteed minimum");

struct Params {
    const float *x, *c, *ctx, *c_ctx, *w_mod, *b_mod, *norm1_g, *norm2_g, *final_g, *w_in, *ml_conv_w, *ml_gate_b, *ml_norm_g, *hy_conv_w,
        *hy_w1, *hy_b1, *hy_w2, *hy_b2, *hy_w3, *hy_freq, *hy_bias, *w_proj_ml, *w_proj_hy, *w_out, *peer_wq, *peer_keys, *peer_u, *peer_v;
    float* out; unsigned char* ws;
    int ph_lo, ph_hi;
};

__device__ __forceinline__ int otid() { int t = threadIdx.x; asm volatile("" : "+v"(t)); return t; }
__device__ __forceinline__ bf16_t f2bf(float f) { unsigned u = __float_as_uint(f); u += 0x7FFFu + ((u >> 16) & 1u); return (bf16_t)(u >> 16); }
__device__ __forceinline__ float bf2f(bf16_t b) { return __uint_as_float(((unsigned)b) << 16); }
__device__ __forceinline__ unsigned pk2(float lo, float hi) { return (unsigned)f2bf(lo) | ((unsigned)f2bf(hi) << 16); }
__device__ __forceinline__ float blo(unsigned w) { return __uint_as_float(w << 16); }
__device__ __forceinline__ float bhi(unsigned w) { return __uint_as_float(w & 0xffff0000u); }
__device__ __forceinline__ float sigmoidf_(float x) { return 1.0f / (1.0f + __expf(-x)); }
__device__ __forceinline__ float siluf_(float x) { return x / (1.0f + __expf(-x)); }
__device__ __forceinline__ float wave_sum(float v) {
#pragma unroll
    for (int o = 32; o >= 1; o >>= 1) v += __shfl_xor(v, o);
    return v;
}
__device__ __forceinline__ f32x4 mfma16(bf16x8 a, bf16x8 b, f32x4 c) { return __builtin_amdgcn_mfma_f32_16x16x32_bf16(a, b, c, 0, 0, 0); }

__device__ __forceinline__ void p0_gemv_hdn(const Params& p, unsigned char* lds) {
    const int tid = otid();
    float* MODP = (float*)(p.ws + WS_MODP);
    const int gthreads = gridDim.x * NT;
    for (int item = blockIdx.x * NT + tid; item < KS * 3072; item += gthreads) {
        const int ks = item / 3072, cg4 = item % 3072;
        f32x4 a0 = {0.f, 0.f, 0.f, 0.f}, a1 = {0.f, 0.f, 0.f, 0.f};
        const int k0 = ks * (D / KS);
        for (int k = k0; k < k0 + D / KS; ++k) {
            const f32x4 w = *(const f32x4*)(p.w_mod + (size_t)k * 12288 + cg4 * 4);
            const float s0 = siluf_(p.c[k]), s1 = siluf_(p.c_ctx[k]);
            a0 += w * s0; a1 += w * s1;
        }
        *(f32x4*)(MODP + ((size_t)(ks * 2 + 0) * 12288) + cg4 * 4) = a0;
        *(f32x4*)(MODP + ((size_t)(ks * 2 + 1) * 12288) + cg4 * 4) = a1;
    }
    bf16_t* HDN = (bf16_t*)(p.ws + WS_HDN);
    float* h1s = (float*)lds;
    const int tt = tid >> 6, j = tid & 63;
    float w2c[64];
#pragma unroll
    for (int i = 0; i < 64; ++i) w2c[i] = p.hy_w2[i * 64 + j];
    for (int u = blockIdx.x; u < L / 8; u += gridDim.x) {
        const int t = u * 8 + tt;
        const float tn = (float)t / (float)L;
        float s = p.hy_b1[j] + tn * p.hy_w1[j];
#pragma unroll
        for (int b = 0; b < 8; ++b) {
            const float band = 1e-4f + (7.0f - 1e-4f) * (float)b / 7.0f;
            const float ang = (6.283185307179586f / (float)L) * (float)t * band;
            float sn, cs; __sincosf(ang, &sn, &cs);
            s += cs * p.hy_w1[(1 + b) * 64 + j] - sn * p.hy_w1[(9 + b) * 64 + j];
        }
        const float fr = p.hy_freq[j];
        __syncthreads();
        h1s[tt * 64 + j] = __sinf(fr * s);
        __syncthreads();
        float s2 = p.hy_b2[j];
#pragma unroll
        for (int i4 = 0; i4 < 16; ++i4) { const f32x4 hv = *(const f32x4*)(h1s + tt * 64 + i4 * 4); s2 += hv[0] * w2c[i4 * 4] + hv[1] * w2c[i4 * 4 + 1] + hv[2] * w2c[i4 * 4 + 2] + hv[3] * w2c[i4 * 4 + 3]; }
        HDN[(size_t)t * 64 + j] = f2bf(__sinf(fr * s2));
    }
    __syncthreads();
}

struct TGroup { const float* src; int ld, k0, n0; bf16_t* dst; };
__device__ __forceinline__ TGroup p1_group(const Params& p, int tix) {
    const int NG_IN = 256 * 8, NG_SQ = 32 * 8;
    TGroup g;
    if (tix < NG_IN) {
        const int ct = tix >> 3, kg = tix & 7;
        const int dc = ct * 64;
        g.src = p.w_in; g.ld = INW; g.k0 = kg * 256;
        if (dc < 6144) { g.n0 = dc; g.dst = (bf16_t*)(p.ws + WS_WREST) + (size_t)dc * D; }
        else if (dc < 10240) { g.n0 = 12320 + (dc - 6144); g.dst = (bf16_t*)(p.ws + WS_WREST) + (size_t)dc * D; }
        else { g.n0 = 6176 + (dc - 10240); g.dst = (bf16_t*)(p.ws + WS_WHY) + (size_t)(dc - 10240) * D; }
    } else {
        const int q = tix - NG_IN, wsel = q / NG_SQ, r = q % NG_SQ, ct = r >> 3, kg = r & 7;
        g.src = wsel == 0 ? p.w_proj_ml : wsel == 1 ? p.w_proj_hy : wsel == 2 ? p.w_out : p.peer_wq; g.ld = D; g.k0 = kg * 256; g.n0 = ct * 64;
        g.dst = (bf16_t*)(p.ws + (wsel == 0 ? WS_WPM : wsel == 1 ? WS_WPH : wsel == 2 ? WS_WO : WS_WQ)) + (size_t)ct * 64 * D;
    }
    return g;
}
__device__ __forceinline__ void tg_load(const TGroup& g, int tid, f32x4 (&v)[4][2]) {
#pragma unroll
    for (int q = 0; q < 4; ++q)
#pragma unroll
        for (int i = 0; i < 2; ++i) { const int r = (tid >> 4) + 32 * i, c4 = tid & 15; v[q][i] = *(const f32x4*)(g.src + (size_t)(g.k0 + q * 64 + r) * g.ld + g.n0 + c4 * 4); }
}
__device__ __forceinline__ void tg_store(const TGroup& g, int tid, const f32x4 (&v)[4][2], unsigned char* lds) {
    float* T = (float*)lds;
#pragma unroll
    for (int q = 0; q < 4; ++q)
#pragma unroll
        for (int i = 0; i < 2; ++i) { const int r = (tid >> 4) + 32 * i, c4 = tid & 15; float* t = T + q * 64 * 65 + r * 65 + c4 * 4;
            t[0] = v[q][i][0]; t[1] = v[q][i][1]; t[2] = v[q][i][2]; t[3] = v[q][i][3]; }
    __syncthreads();
    {
        const int n = tid >> 3, k8 = tid & 7;
#pragma unroll
        for (int q = 0; q < 4; ++q) {
            const float* t = T + q * 64 * 65;
            u32x4 w;
            w.x = pk2(t[(k8 * 8 + 0) * 65 + n], t[(k8 * 8 + 1) * 65 + n]); w.y = pk2(t[(k8 * 8 + 2) * 65 + n], t[(k8 * 8 + 3) * 65 + n]);
            w.z = pk2(t[(k8 * 8 + 4) * 65 + n], t[(k8 * 8 + 5) * 65 + n]); w.w = pk2(t[(k8 * 8 + 6) * 65 + n], t[(k8 * 8 + 7) * 65 + n]);
            *(u32x4*)(g.dst + (size_t)n * D + g.k0 + q * 64 + k8 * 8) = w;
        }
    }
    __syncthreads();
}
__device__ __forceinline__ void p1_weights(const Params& p, unsigned char* lds) {
    const int tid = otid();
    if (blockIdx.x < 48) {
        const int n = blockIdx.x * NT + tid; const int v = n / 12288, nn = n % 12288;
        const float* MODP = (const float*)(p.ws + WS_MODP);
        float s = p.b_mod[nn];
        for (int ks = 0; ks < KS; ++ks) s += MODP[(size_t)(ks * 2 + v) * 12288 + nn];
        ((float*)(p.ws + WS_MOD))[n] = s;
    }
    const int NG = 256 * 8 + 4 * 32 * 8;
    {
        f32x4 va[4][2], vb[4][2];
        int tix = blockIdx.x;
        TGroup ga = p1_group(p, tix < NG ? tix : 0), gb = ga;
        if (tix < NG) tg_load(ga, tid, va);
#pragma unroll 1
        for (; tix < NG; tix += 2 * gridDim.x) {
            const int t2 = tix + gridDim.x, t3 = tix + 2 * gridDim.x;
            if (t2 < NG) { gb = p1_group(p, t2); tg_load(gb, tid, vb); }
            tg_store(ga, tid, va, lds);
            if (t3 < NG) { ga = p1_group(p, t3); tg_load(ga, tid, va); }
            if (t2 < NG) tg_store(gb, tid, vb, lds);
        }
    }
    for (int item = blockIdx.x * NT + tid; item < 32 * D; item += gridDim.x * NT) {
        const int k = item >> 5, j = item & 31;
        ((bf16_t*)(p.ws + WS_WREST))[(size_t)(C_GT + j) * D + k] = f2bf(p.w_in[(size_t)k * INW + 6144 + j]);
    }
}

__device__ __forceinline__ void p1_filters(const Params& p) {
    const int tid = otid(), lane = tid & 63, wv = tid >> 6, fr = lane & 15, fq = lane >> 4;
    const bf16_t* HDN = (const bf16_t*)(p.ws + WS_HDN);
    bf16_t* FILT = (bf16_t*)(p.ws + WS_FILT);
    const float dmin = -3.0701134573253944f, dmax = -15.350567286626972f;
    for (int task = blockIdx.x * 8 + wv; task < 512 * 8; task += gridDim.x * 8) {
        const int cgp = task >> 3, tpart = task & 7;
        const int col = cgp * 16 + fr;
        bf16x8 bw[2];
#pragma unroll
        for (int kk = 0; kk < 2; ++kk)
#pragma unroll
            for (int e = 0; e < 8; ++e) bw[kk][e] = (short)f2bf(p.hy_w3[(size_t)(kk * 32 + fq * 8 + e) * 8192 + col]);
        const float delta = fabsf(dmin + (dmax - dmin) * (float)(col & 2047) / 2047.0f);
#pragma unroll 1
        for (int tt0 = 0; tt0 < 64; tt0 += 8) {
            bf16x8 af[8][2];
#pragma unroll
            for (int q = 0; q < 8; ++q)
#pragma unroll
                for (int kk = 0; kk < 2; ++kk) af[q][kk] = *(const bf16x8*)(HDN + (size_t)((tpart * 64 + tt0 + q) * 16 + fr) * 64 + kk * 32 + fq * 8);
#pragma unroll
            for (int q = 0; q < 8; ++q) {
                f32x4 acc = {0.f, 0.f, 0.f, 0.f};
                acc = mfma16(af[q][0], bw[0], acc); acc = mfma16(af[q][1], bw[1], acc);
                const int t0 = (tpart * 64 + tt0 + q) * 16 + fq * 4;
                float v[4];
#pragma unroll
                for (int j = 0; j < 4; ++j) v[j] = acc[j] * (__expf(-((float)(t0 + j) / (float)L) * delta) + 0.05f);
                u32x2 w; w.x = pk2(v[0], v[1]); w.y = pk2(v[2], v[3]);
                *(u32x2*)(FILT + (size_t)col * 8192 + t0) = w;
            }
        }
    }
}

template <int MODE>
__device__ __forceinline__ void p_rownorm(const Params& p) {
    const int tid = otid(), lane = tid & 63, wv = tid >> 6;
    const float* MOD = (const float*)(p.ws + WS_MOD);
    const int nrows = MODE == 0 ? LT : L;
    bf16_t* O = (bf16_t*)(p.ws + (MODE == 0 ? WS_U : WS_VL));
    const float* gn = MODE == 0 ? p.norm1_g : p.norm2_g;
    for (int row = blockIdx.x * 8 + wv; row < nrows; row += gridDim.x * 8) {
        const float* src = MODE == 0 ? (row < L ? p.x + (size_t)row * D : p.ctx + (size_t)(row - L) * D) : (const float*)(p.ws + WS_HLAT) + (size_t)row * D;
        const float* md = MOD + ((MODE == 0 && row >= L) ? 12288 : 0) + (MODE == 0 ? 0 : 3 * D);
        f32x4 v[8]; float ss = 0.f;
#pragma unroll
        for (int i = 0; i < 8; ++i) { v[i] = *(const f32x4*)(src + (lane + 64 * i) * 4); ss += v[i][0] * v[i][0] + v[i][1] * v[i][1] + v[i][2] * v[i][2] + v[i][3] * v[i][3]; }
        ss = wave_sum(ss);
        const float rinv = rsqrtf(ss * (1.0f / D) + EPS);
#pragma unroll
        for (int i = 0; i < 8; ++i) {
            const int c = (lane + 64 * i) * 4;
            const f32x4 g = *(const f32x4*)(gn + c), sh = *(const f32x4*)(md + c), sc = *(const f32x4*)(md + D + c);
            const f32x4 y = v[i] * rinv * g * (sc + 1.0f) + sh;
            u32x2 w; w.x = pk2(y[0], y[1]); w.y = pk2(y[2], y[3]);
            *(u32x2*)(O + (size_t)row * D + c) = w;
        }
    }
}

__device__ __forceinline__ void mini_gemm_task(const bf16_t* A, const bf16_t* Bt, bf16_t* O, unsigned char* lds) {
    const int tid = otid(), lane = tid & 63, wv = tid >> 6, fr = lane & 15, fq = lane >> 4;
    f32x4 acc[4][4];
#pragma unroll
    for (int m = 0; m < 4; ++m)
#pragma unroll
        for (int n = 0; n < 4; ++n) acc[m][n] = (f32x4){0.f, 0.f, 0.f, 0.f};
#pragma unroll 1
    for (int ks = 0; ks < 8; ks += 2) {
        bf16x8 af[2][4], bfr[2][4];
#pragma unroll
        for (int u = 0; u < 2; ++u)
#pragma unroll
            for (int m = 0; m < 4; ++m) { const int k = wv * 256 + (ks + u) * 32 + fq * 8;
                af[u][m] = *(const bf16x8*)(A + (size_t)(m * 16 + fr) * D + k); bfr[u][m] = *(const bf16x8*)(Bt + (size_t)(m * 16 + fr) * D + k); }
#pragma unroll
        for (int u = 0; u < 2; ++u)
#pragma unroll
            for (int m = 0; m < 4; ++m)
#pragma unroll
                for (int n = 0; n < 4; ++n) acc[m][n] = mfma16(af[u][m], bfr[u][n], acc[m][n]);
    }
    float* red = (float*)lds;
    __syncthreads();
#pragma unroll
    for (int m = 0; m < 4; ++m)
#pragma unroll
        for (int n = 0; n < 4; ++n) *(f32x4*)(red + (((size_t)wv * 16 + m * 4 + n) * 64 + lane) * 4) = acc[m][n];
    __syncthreads();
#pragma unroll
    for (int i = 0; i < 2; ++i) {
        const int g = tid + NT * i, tile = g >> 6, ln = g & 63, m = tile >> 2, n = tile & 3;
        f32x4 sum = {0.f, 0.f, 0.f, 0.f};
#pragma unroll
        for (int w = 0; w < 8; ++w) sum += *(const f32x4*)(red + (((size_t)w * 16 + tile) * 64 + ln) * 4);
#pragma unroll
        for (int j = 0; j < 4; ++j) O[(size_t)(m * 16 + (ln >> 4) * 4 + j) * NREST + n * 16 + (ln & 15)] = f2bf(sum[j]);
    }
    __syncthreads();
}
__device__ __forceinline__ void p3_side_tasks(const Params& p, unsigned char* lds) {
    const bf16_t* U = (const bf16_t*)(p.ws + WS_U); const bf16_t* W = (const bf16_t*)(p.ws + WS_WREST); bf16_t* P1 = (bf16_t*)(p.ws + WS_P1);
    for (int task = blockIdx.x; task < 256 + 132; task += gridDim.x) {
        if (task < 256) { const int rb = task >> 6, cb = task & 63;
            mini_gemm_task(U + (size_t)(L + rb * 64) * D, W + (size_t)(cb * 64) * D, P1 + (size_t)(L + rb * 64) * NREST + cb * 64, lds); }
        else { const int rb = task - 256;
            mini_gemm_task(U + (size_t)(rb * 64) * D, W + (size_t)C_GT * D, P1 + (size_t)(rb * 64) * NREST + C_GT, lds); }
    }
}

__device__ __forceinline__ int pos_row(int dir, int pos) {
    return dir == 0 ? (pos < LC ? L + pos : pos - LC) : (pos < LC ? L + (LC - 1 - pos) : (L - 1) - (pos - LC));
}
__device__ __forceinline__ float logsigmoidf_(float x) { return fminf(x, 0.f) - log1pf(__expf(-fabsf(x))); }
__device__ __forceinline__ void p4_conv_gates(const Params& p, unsigned char* lds) {
    const int tid = otid(), lane = tid & 63;
    const bf16_t* P1 = (const bf16_t*)(p.ws + WS_P1);
    bf16_t* QK = (bf16_t*)(p.ws + WS_QK);
    if (blockIdx.x < NCH) {
        const int chain = blockIdx.x, dir = chain >> 3, head = chain & 7, wv = tid >> 6;
        float* GB = (float*)(p.ws + WS_GB) + (size_t)chain * LT; float* GA = (float*)(p.ws + WS_GA) + (size_t)chain * LT; float* GM = (float*)(p.ws + WS_GM) + (size_t)chain * LT;
        const float bi = p.ml_gate_b[(dir * 2) * 8 + head], bfg = p.ml_gate_b[(dir * 2 + 1) * 8 + head];
        const int ci = C_GT + (dir * 2) * 8 + head, cfc = C_GT + (dir * 2 + 1) * 8 + head;
        float* red = (float*)lds;
        constexpr int SEG = 17;
        const int p0 = tid * SEG;
        float gf[SEG], ga[SEG];
        float lsum = 0.f;
#pragma unroll
        for (int i = 0; i < SEG; ++i) {
            const int pos = p0 + i; const bool ok = pos < LT; const int r = pos_row(dir, ok ? pos : 0);
            gf[i] = ok ? logsigmoidf_(bf2f(P1[(size_t)r * NREST + cfc]) + bfg) : 0.f;
            ga[i] = ok ? bf2f(P1[(size_t)r * NREST + ci]) + bi : -1e30f;
            lsum += gf[i];
        }
        float incl = lsum;
#pragma unroll
        for (int o = 1; o < 64; o <<= 1) { const float t = __shfl_up(incl, o); if (lane >= o) incl += t; }
        __syncthreads();
        if (lane == 63) red[wv] = incl;
        __syncthreads();
        float woff = 0.f;
        for (int i = 0; i < wv; ++i) woff += red[i];
        float run = woff + incl - lsum, lmax = -1e30f;
#pragma unroll
        for (int i = 0; i < SEG; ++i) {
            const int pos = p0 + i;
            run += gf[i];
            ga[i] = ga[i] - run;
            if (pos < LT) { GB[pos] = run; GA[pos] = ga[i]; lmax = fmaxf(lmax, ga[i]); }
        }
        float imax = lmax;
#pragma unroll
        for (int o = 1; o < 64; o <<= 1) { const float t = __shfl_up(imax, o); if (lane >= o) imax = fmaxf(imax, t); }
        __syncthreads();
        if (lane == 63) red[wv] = imax;
        __syncthreads();
        float pm = __shfl_up(imax, 1); if (lane == 0) pm = -1e30f;
        for (int i = 0; i < wv; ++i) pm = fmaxf(pm, red[i]);
#pragma unroll
        for (int i = 0; i < SEG; ++i) { const int pos = p0 + i; if (pos < LT) { pm = fmaxf(pm, ga[i]); GM[pos] = pm; } }
        __syncthreads();
    }
    const float qs = 0.08838834764831845f;
    for (int g = blockIdx.x * NT + tid; g < 256 * 64 * 8; g += gridDim.x * NT) {
        const int c8 = (g & 255) * 8, gc = (g >> 8) & 63, seg = g >> 14;
        float w[9][8];
#pragma unroll
        for (int k = 0; k < 9; ++k) { const f32x4 w0 = *(const f32x4*)(p.ml_conv_w + (size_t)k * D + c8), w1 = *(const f32x4*)(p.ml_conv_w + (size_t)k * D + c8 + 4);
            w[k][0] = w0[0]; w[k][1] = w0[1]; w[k][2] = w0[2]; w[k][3] = w0[3]; w[k][4] = w1[0]; w[k][5] = w1[1]; w[k][6] = w1[2]; w[k][7] = w1[3]; }
        const float sc = c8 < 1024 ? qs : 1.0f;
        u32x4 win[3][3];
        const u32x4 zero4 = {0u, 0u, 0u, 0u};
#define CV_LOAD(slot_, r_) do { _Pragma("unroll") for (int dc = 0; dc < 3; ++dc) { const int c2_ = gc + dc - 1; const bool ok_ = (r_) >= 0 && (r_) < 128 && c2_ >= 0 && c2_ < 64; \
            win[slot_][dc] = ok_ ? *(const u32x4*)(P1 + (size_t)((r_) * 64 + c2_) * NREST + C_QK + c8) : zero4; } } while (0)
        const int r0 = seg * 16;
        CV_LOAD(0, r0 - 1); CV_LOAD(1, r0);
#pragma unroll 1
        for (int rr = 0; rr < 16; rr += 3) {
#pragma unroll
            for (int ph = 0; ph < 3; ++ph) {
                const int r = r0 + rr + ph;
                if (rr + ph < 16) {
                    CV_LOAD((ph + 2) % 3, r + 1);
                    float acc[8];
#pragma unroll
                    for (int e = 0; e < 8; ++e) acc[e] = 0.f;
#pragma unroll
                    for (int dr = 0; dr < 3; ++dr)
#pragma unroll
                        for (int dc = 0; dc < 3; ++dc) {
                            const u32x4 v = win[(ph + dr) % 3][dc]; const int k = dr * 3 + dc;
                            acc[0] += blo(v.x) * w[k][0]; acc[1] += bhi(v.x) * w[k][1]; acc[2] += blo(v.y) * w[k][2]; acc[3] += bhi(v.y) * w[k][3];
                            acc[4] += blo(v.z) * w[k][4]; acc[5] += bhi(v.z) * w[k][5]; acc[6] += blo(v.w) * w[k][6]; acc[7] += bhi(v.w) * w[k][7];
                        }
                    u32x4 o;
                    o.x = pk2(siluf_(acc[0]) * sc, siluf_(acc[1]) * sc); o.y = pk2(siluf_(acc[2]) * sc, siluf_(acc[3]) * sc);
                    o.z = pk2(siluf_(acc[4]) * sc, siluf_(acc[5]) * sc); o.w = pk2(siluf_(acc[6]) * sc, siluf_(acc[7]) * sc);
                    *(u32x4*)(QK + (size_t)(r * 64 + gc) * D + c8) = o;
                }
            }
        }
    }
    for (int item = blockIdx.x * NT + tid; item < LC * 256; item += gridDim.x * NT) {
        const int i0 = item >> 8, c8 = (item & 255) * 8;
        float acc[8];
#pragma unroll
        for (int e = 0; e < 8; ++e) acc[e] = 0.f;
#pragma unroll
        for (int dc = 0; dc < 3; ++dc) {
            const int i2 = i0 + dc - 1;
            if (i2 < 0 || i2 >= LC) continue;
            const u32x4 v = *(const u32x4*)(P1 + (size_t)(L + i2) * NREST + C_QK + c8);
            const f32x4 w0 = *(const f32x4*)(p.ml_conv_w + (size_t)(3 + dc) * D + c8), w1 = *(const f32x4*)(p.ml_conv_w + (size_t)(3 + dc) * D + c8 + 4);
            acc[0] += blo(v.x) * w0[0]; acc[1] += bhi(v.x) * w0[1]; acc[2] += blo(v.y) * w0[2]; acc[3] += bhi(v.y) * w0[3];
            acc[4] += blo(v.z) * w1[0]; acc[5] += bhi(v.z) * w1[1]; acc[6] += blo(v.w) * w1[2]; acc[7] += bhi(v.w) * w1[3];
        }
        const float sc = c8 < 1024 ? qs : 1.0f;
        u32x4 w;
        w.x = pk2(siluf_(acc[0]) * sc, siluf_(acc[1]) * sc); w.y = pk2(siluf_(acc[2]) * sc, siluf_(acc[3]) * sc);
        w.z = pk2(siluf_(acc[4]) * sc, siluf_(acc[5]) * sc); w.w = pk2(siluf_(acc[6]) * sc, siluf_(acc[7]) * sc);
        *(u32x4*)(QK + (size_t)(L + i0) * D + c8) = w;
    }
}

__device__ __forceinline__ void p5_local_states(const Params& p, unsigned char* lds) {
    const int tid = otid(), lane = tid & 63, wv = tid >> 6, fr = lane & 15, fq = lane >> 4;
    const bf16_t* P1 = (const bf16_t*)(p.ws + WS_P1);
    const bf16_t* QK = (const bf16_t*)(p.ws + WS_QK);
    bf16_t* Vt = (bf16_t*)lds;
    bf16_t* Kt = (bf16_t*)(lds + 256 * 72 * 2);
    float* red = (float*)(lds + 256 * 72 * 2 + 128 * 72 * 2);
    float* wg = red + 16;
    for (int u0 = blockIdx.x; u0 < NCH * (NCK - 1); u0 += gridDim.x) {
        const int chain = u0 / (NCK - 1), c = u0 % (NCK - 1), dir = chain >> 3, head = chain & 7, u = chain * NCK + c;
        const float* GA = (const float*)(p.ws + WS_GA) + (size_t)chain * LT + c * TC;
        float a = tid < TC ? GA[tid] : -1e30f;
        float m = a;
#pragma unroll
        for (int o = 32; o >= 1; o >>= 1) m = fmaxf(m, __shfl_xor(m, o));
        __syncthreads();
        if (lane == 0) red[wv] = m;
        __syncthreads();
        float mloc = red[0];
#pragma unroll
        for (int i = 1; i < 8; ++i) mloc = fmaxf(mloc, red[i]);
        if (tid < TC) wg[tid] = __expf(a - mloc);
        f32x4 acc[2][8];
#pragma unroll
        for (int i = 0; i < 2; ++i)
#pragma unroll
            for (int j = 0; j < 8; ++j) acc[i][j] = (f32x4){0.f, 0.f, 0.f, 0.f};
        float nacc = 0.f;
        u32x4 vreg[4], kreg[2];
#define P5_FETCH(sb_) do { \
            _Pragma("unroll") for (int i = 0; i < 4; ++i) { const int item = tid + NT * i, s_ = item >> 5, v8 = item & 31; const int r = pos_row(dir, c * TC + (sb_) * 64 + s_); \
                vreg[i] = *(const u32x4*)(P1 + (size_t)r * NREST + C_V + head * 256 + v8 * 8); } \
            _Pragma("unroll") for (int i = 0; i < 2; ++i) { const int item = tid + NT * i, s_ = item >> 4, d8 = item & 15; const int r = pos_row(dir, c * TC + (sb_) * 64 + s_); \
                kreg[i] = *(const u32x4*)(QK + (size_t)r * D + 1024 + head * 128 + d8 * 8); } } while (0)
        P5_FETCH(0);
        for (int sb = 0; sb < 4; ++sb) {
            __syncthreads();
#pragma unroll
            for (int i = 0; i < 4; ++i) { const int item = tid + NT * i, s_ = item >> 5, v8 = item & 31; *(u32x4*)(Vt + s_ * 264 + v8 * 8) = vreg[i]; }
#pragma unroll
            for (int i = 0; i < 2; ++i) {
                const int item = tid + NT * i, s_ = item >> 4, d8 = item & 15;
                const u32x4 w = kreg[i];
                const float g = wg[sb * 64 + s_];
                u32x4 o; o.x = pk2(blo(w.x) * g, bhi(w.x) * g); o.y = pk2(blo(w.y) * g, bhi(w.y) * g); o.z = pk2(blo(w.z) * g, bhi(w.z) * g); o.w = pk2(blo(w.w) * g, bhi(w.w) * g);
                *(u32x4*)(Kt + s_ * 136 + d8 * 8) = o;
            }
            __syncthreads();
            if (sb < 3) P5_FETCH(sb + 1);
            if (tid < 128) { float s2 = 0.f; for (int s_ = 0; s_ < 64; ++s_) s2 += bf2f(Kt[s_ * 136 + tid]); nacc += s2; }
#pragma unroll
            for (int kk = 0; kk < 2; ++kk) {
                bf16x8 af[2], bfr[8];
                const int trow = kk * 32 + fq * 8 + ((lane & 15) >> 2), tcol = (lane & 3) * 4;
#pragma unroll
                for (int mt = 0; mt < 2; ++mt) { const bf16_t* vb = Vt + trow * 264 + wv * 32 + mt * 16 + tcol;
                    const s16x4 lo = __builtin_amdgcn_ds_read_tr16_b64_v4i16((LAS s16x4*)(vb)), hi = __builtin_amdgcn_ds_read_tr16_b64_v4i16((LAS s16x4*)(vb + 4 * 264));
                    af[mt] = (bf16x8){lo[0], lo[1], lo[2], lo[3], hi[0], hi[1], hi[2], hi[3]}; }
#pragma unroll
                for (int nt = 0; nt < 8; ++nt) { const bf16_t* kb = Kt + trow * 136 + nt * 16 + tcol;
                    const s16x4 lo = __builtin_amdgcn_ds_read_tr16_b64_v4i16((LAS s16x4*)(kb)), hi = __builtin_amdgcn_ds_read_tr16_b64_v4i16((LAS s16x4*)(kb + 4 * 136));
                    bfr[nt] = (bf16x8){lo[0], lo[1], lo[2], lo[3], hi[0], hi[1], hi[2], hi[3]}; }
#pragma unroll
                for (int mt = 0; mt < 2; ++mt)
#pragma unroll
                    for (int nt = 0; nt < 8; ++nt) acc[mt][nt] = mfma16(af[mt], bfr[nt], acc[mt][nt]);
            }
        }
        float* SL = (float*)(p.ws + WS_SLOC) + (size_t)u * 256 * 128;
#pragma unroll
        for (int mt = 0; mt < 2; ++mt)
#pragma unroll
            for (int nt = 0; nt < 8; ++nt)
#pragma unroll
                for (int j = 0; j < 4; ++j) SL[(size_t)(wv * 32 + mt * 16 + fq * 4 + j) * 128 + nt * 16 + fr] = acc[mt][nt][j];
        if (tid < 128) ((float*)(p.ws + WS_NLOC))[(size_t)u * 128 + tid] = nacc;
        if (tid == 0) ((float*)(p.ws + WS_MLOC))[u] = mloc;
    }
    __syncthreads();
}

__device__ __forceinline__ void p6_scan(const Params& p) {
    const int tid = otid();
    const float* MLOC = (const float*)(p.ws + WS_MLOC);
    constexpr int EPC = 256 * 128 + 128;
    for (int item = blockIdx.x * NT + tid; item < NCH * EPC; item += gridDim.x * NT) {
        const int chain = item / EPC, e = item % EPC;
        float S = 0.f, mrun = -1e30f;
        const bool isS = e < 256 * 128;
#pragma unroll 1
        for (int c0 = 0; c0 < NCK; c0 += 11) {
            float loc[11];
#pragma unroll
            for (int i = 0; i < 11; ++i) { const int u = chain * NCK + c0 + i;
                loc[i] = isS ? ((const float*)(p.ws + WS_SLOC))[(size_t)u * 256 * 128 + e] : ((const float*)(p.ws + WS_NLOC))[(size_t)u * 128 + (e - 256 * 128)]; }
#pragma unroll
            for (int i = 0; i < 11; ++i) {
                const int u = chain * NCK + c0 + i;
                if (isS) ((bf16_t*)(p.ws + WS_SPRE))[(size_t)u * 256 * 128 + e] = f2bf(S);
                else ((float*)(p.ws + WS_NPRE))[(size_t)u * 128 + (e - 256 * 128)] = S;
                if (e == 0) ((float*)(p.ws + WS_MPRE))[u] = mrun;
                if (c0 + i < NCK - 1) {
                    const float ml = MLOC[u];
                    const float mnew = fmaxf(mrun, ml);
                    S = S * __expf(mrun - mnew) + loc[i] * __expf(ml - mnew);
                    mrun = mnew;
                }
            }
        }
    }
}

__device__ __forceinline__ void p7_mlstm_out(const Params& p, unsigned char* lds) {
    const int tid = otid(), lane = tid & 63, wv = tid >> 6, fr = lane & 15, fq = lane >> 4;
    const bf16_t* P1 = (const bf16_t*)(p.ws + WS_P1);
    const bf16_t* QK = (const bf16_t*)(p.ws + WS_QK);
    bf16_t* Qs = (bf16_t*)lds;
    float* rowM = (float*)(lds + 64 * 136 * 2);
    float* rowB = rowM + 64;
    float* denS = rowB + 64;
    float* asS = denS + 64;
    float* npS = asS + 64;
    float* ssq = npS + 128;
    unsigned char* big = lds + 64 * 136 * 2 + 2048;
    bf16_t* Ss = (bf16_t*)big;
    bf16_t* Ks = (bf16_t*)big;
    bf16_t* Vt = (bf16_t*)(big + 64 * 136 * 2);
    bf16_t* Ps = (bf16_t*)(big + 64 * 136 * 2 + 256 * 72 * 2);
    const int rt = wv & 3, ch = wv >> 2;
    for (int u = blockIdx.x; u < 8 * 128; u += gridDim.x) {
        const int head = u >> 7, tb = u & 127;
        f32x4 hs[8];
#pragma unroll
        for (int j = 0; j < 8; ++j) hs[j] = (f32x4){0.f, 0.f, 0.f, 0.f};
        __syncthreads();
        {
#pragma unroll
            for (int i = 0; i < 2; ++i) { const int item = tid + NT * i, r = item >> 4, c8 = item & 15;
                *(u32x4*)(Qs + r * 136 + c8 * 8) = *(const u32x4*)(QK + (size_t)(tb * 64 + r) * D + head * 128 + c8 * 8); }
        }
        for (int dir = 0; dir < 2; ++dir) {
            const int chain = dir * 8 + head, pb = dir ? 131 - tb : 4 + tb, c = pb >> 2;
            const int uu = chain * NCK + c;
            const float* GA = (const float*)(p.ws + WS_GA) + (size_t)chain * LT; const float* GB = (const float*)(p.ws + WS_GB) + (size_t)chain * LT; const float* GM = (const float*)(p.ws + WS_GM) + (size_t)chain * LT;
            const float mprev = ((const float*)(p.ws + WS_MPRE))[uu];
            __syncthreads();
            if (tid < 64) { const int pos = dir ? pb * 64 + 63 - tid : pb * 64 + tid; rowM[tid] = GM[pos]; rowB[tid] = GB[pos]; }
            if (tid >= 64 && tid < 192) npS[tid - 64] = ((const float*)(p.ws + WS_NPRE))[(size_t)uu * 128 + tid - 64];
            {
                const bf16_t* SP = (const bf16_t*)(p.ws + WS_SPRE) + (size_t)uu * 256 * 128;
#pragma unroll
                for (int i = 0; i < 8; ++i) { const int item = tid + NT * i, r = item >> 4, c8 = item & 15;
                    *(u32x4*)(Ss + r * 136 + c8 * 8) = *(const u32x4*)(SP + (size_t)r * 128 + c8 * 8); }
            }
            __syncthreads();
            u32x4 kreg[2], vreg[4]; float areg = 0.f;
#define P7_FETCH(pb2_) do { const int tb2_ = dir ? 131 - (pb2_) : (pb2_) - 4; \
                _Pragma("unroll") for (int i = 0; i < 2; ++i) { const int item = tid + NT * i, r = item >> 4, c8 = item & 15; kreg[i] = *(const u32x4*)(QK + (size_t)(tb2_ * 64 + r) * D + 1024 + head * 128 + c8 * 8); } \
                _Pragma("unroll") for (int i = 0; i < 4; ++i) { const int item = tid + NT * i, s_ = item >> 5, v8 = item & 31; vreg[i] = *(const u32x4*)(P1 + (size_t)(tb2_ * 64 + s_) * NREST + C_V + head * 256 + v8 * 8); } \
                if (tid < 64) { const int pos = dir ? (pb2_) * 64 + 63 - tid : (pb2_) * 64 + tid; areg = GA[pos]; } } while (0)
            P7_FETCH(c * 4);
            f32x4 acc[8];
#pragma unroll
            for (int j = 0; j < 8; ++j) acc[j] = (f32x4){0.f, 0.f, 0.f, 0.f};
#pragma unroll
            for (int kk = 0; kk < 4; ++kk) {
                const bf16x8 af = *(const bf16x8*)(Qs + (rt * 16 + fr) * 136 + kk * 32 + fq * 8);
#pragma unroll
                for (int j = 0; j < 8; ++j) { const bf16x8 bfr = *(const bf16x8*)(Ss + (ch * 128 + j * 16 + fr) * 136 + kk * 32 + fq * 8); acc[j] = mfma16(af, bfr, acc[j]); }
            }
            {
                float sc[4];
#pragma unroll
                for (int j2 = 0; j2 < 4; ++j2) sc[j2] = __expf(mprev - rowM[rt * 16 + fq * 4 + j2]);
#pragma unroll
                for (int j = 0; j < 8; ++j)
#pragma unroll
                    for (int j2 = 0; j2 < 4; ++j2) acc[j][j2] *= sc[j2];
            }
            float den = 0.f;
            if (tid < 64) { float s = 0.f; for (int d = 0; d < 128; ++d) s += bf2f(Qs[tid * 136 + d]) * npS[d]; den = s * __expf(mprev - rowM[tid]); }
            for (int pb2 = c * 4; pb2 <= pb; ++pb2) {
                __syncthreads();
                {
#pragma unroll
                    for (int i = 0; i < 2; ++i) { const int item = tid + NT * i, r = item >> 4, c8 = item & 15; *(u32x4*)(Ks + r * 136 + c8 * 8) = kreg[i]; }
#pragma unroll
                    for (int i = 0; i < 4; ++i) { const int item = tid + NT * i, s2 = item >> 5, v8 = item & 31; *(u32x4*)(Vt + s2 * 264 + v8 * 8) = vreg[i]; }
                    if (tid < 64) asS[tid] = areg;
                }
                __syncthreads();
                if (pb2 < pb) P7_FETCH(pb2 + 1);
                {
#pragma unroll
                    for (int t2 = 0; t2 < 2; ++t2) {
                        const int st = ch * 2 + t2;
                        f32x4 pa = {0.f, 0.f, 0.f, 0.f};
#pragma unroll
                        for (int kk = 0; kk < 4; ++kk) {
                            const bf16x8 af = *(const bf16x8*)(Qs + (rt * 16 + fr) * 136 + kk * 32 + fq * 8);
                            const bf16x8 bfr = *(const bf16x8*)(Ks + (st * 16 + fr) * 136 + kk * 32 + fq * 8);
                            pa = mfma16(af, bfr, pa);
                        }
                        const int is = st * 16 + fr; const float as = asS[is];
#pragma unroll
                        for (int j2 = 0; j2 < 4; ++j2) {
                            const int it = rt * 16 + fq * 4 + j2;
                            bool ok = true;
                            if (pb2 == pb) ok = dir ? (is >= it) : (is <= it);
                            const float w = ok ? __expf(as - rowM[it]) : 0.f;
                            Ps[it * 72 + is] = f2bf(pa[j2] * w);
                        }
                    }
                }
                __syncthreads();
                if (tid < 64) { float s = 0.f; for (int i = 0; i < 64; ++i) s += bf2f(Ps[tid * 72 + i]); den += s; }
#pragma unroll
                for (int kk = 0; kk < 2; ++kk) {
                    const bf16x8 af = *(const bf16x8*)(Ps + (rt * 16 + fr) * 72 + kk * 32 + fq * 8);
#pragma unroll
                    for (int j = 0; j < 8; ++j) {
                        const bf16_t* vb = Vt + (kk * 32 + fq * 8 + ((lane & 15) >> 2)) * 264 + ch * 128 + j * 16 + (lane & 3) * 4;
                        const s16x4 lo = __builtin_amdgcn_ds_read_tr16_b64_v4i16((LAS s16x4*)(vb)), hi = __builtin_amdgcn_ds_read_tr16_b64_v4i16((LAS s16x4*)(vb + 4 * 264));
                        const bf16x8 bfr = {lo[0], lo[1], lo[2], lo[3], hi[0], hi[1], hi[2], hi[3]};
                        acc[j] = mfma16(af, bfr, acc[j]); }
                }
            }
            if (tid < 64) { const float mt = rowB[tid] + rowM[tid]; denS[tid] = 1.0f / fmaxf(fabsf(den), __expf(-mt)); }
            __syncthreads();
            {
                float dn[4];
#pragma unroll
                for (int j2 = 0; j2 < 4; ++j2) dn[j2] = denS[rt * 16 + fq * 4 + j2];
#pragma unroll
                for (int j = 0; j < 8; ++j)
#pragma unroll
                    for (int j2 = 0; j2 < 4; ++j2) hs[j][j2] += acc[j][j2] * dn[j2];
            }
        }
        {
            float s4[4] = {0.f, 0.f, 0.f, 0.f};
#pragma unroll
            for (int j = 0; j < 8; ++j)
#pragma unroll
                for (int j2 = 0; j2 < 4; ++j2) s4[j2] += hs[j][j2] * hs[j][j2];
#pragma unroll
            for (int j2 = 0; j2 < 4; ++j2) {
#pragma unroll
                for (int o = 1; o <= 8; o <<= 1) s4[j2] += __shfl_xor(s4[j2], o);
            }
            __syncthreads();
            if (fr == 0) {
#pragma unroll
                for (int j2 = 0; j2 < 4; ++j2) ssq[ch * 64 + rt * 16 + fq * 4 + j2] = s4[j2];
            }
            __syncthreads();
            bf16_t* HML = (bf16_t*)(p.ws + WS_HML);
            float* Hs = (float*)big;
#pragma unroll
            for (int j2 = 0; j2 < 4; ++j2) {
                const int it = rt * 16 + fq * 4 + j2;
                const float rinv = rsqrtf((ssq[it] + ssq[64 + it]) * (1.0f / 256.0f) + EPS);
#pragma unroll
                for (int j = 0; j < 8; ++j) Hs[it * 260 + ch * 128 + j * 16 + fr] = hs[j][j2] * rinv;
            }
            __syncthreads();
#pragma unroll
            for (int i = 0; i < 4; ++i) {
                const int item = tid + NT * i, it = item >> 5, c8 = (item & 31) * 8;
                const int trow = tb * 64 + it, col = head * 256 + c8;
                const u32x4 ow = *(const u32x4*)(P1 + (size_t)trow * NREST + C_O + col);
                const f32x4 g0 = *(const f32x4*)(p.ml_norm_g + col), g1 = *(const f32x4*)(p.ml_norm_g + col + 4);
                const f32x4 h0 = *(const f32x4*)(Hs + it * 260 + c8), h1 = *(const f32x4*)(Hs + it * 260 + c8 + 4);
                u32x4 w;
                w.x = pk2(h0[0] * g0[0] * sigmoidf_(blo(ow.x)), h0[1] * g0[1] * sigmoidf_(bhi(ow.x))); w.y = pk2(h0[2] * g0[2] * sigmoidf_(blo(ow.y)), h0[3] * g0[3] * sigmoidf_(bhi(ow.y)));
                w.z = pk2(h1[0] * g1[0] * sigmoidf_(blo(ow.z)), h1[1] * g1[1] * sigmoidf_(bhi(ow.z))); w.w = pk2(h1[2] * g1[2] * sigmoidf_(blo(ow.w)), h1[3] * g1[3] * sigmoidf_(bhi(ow.w)));
                *(u32x4*)(HML + (size_t)trow * D + col) = w;
            }
        }
    }
    __syncthreads();
}

struct cf { float x, y; };
__device__ __forceinline__ cf cmul(cf a, cf b) { return cf{a.x * b.x - a.y * b.y, a.x * b.y + a.y * b.x}; }
__device__ __forceinline__ cf cmulc(cf a, cf b) { return cf{a.x * b.x + a.y * b.y, a.y * b.x - a.x * b.y}; }
constexpr int FM = 8192;
__device__ __forceinline__ int fphys(int i) { return i + (i >> 3); }
constexpr int FARR = (FM + FM / 8) * 8;
__device__ constexpr float c16(int n) { return n==0?1.f: n==1?0.92387953251f: n==2?0.70710678119f: n==3?0.38268343237f: n==4?0.f: n==5?-0.38268343237f: n==6?-0.70710678119f: -0.92387953251f; }
__device__ constexpr float s16(int n) { return n==0?0.f: n==1?0.38268343237f: n==2?0.70710678119f: n==3?0.92387953251f: n==4?1.f: n==5?0.92387953251f: n==6?0.70710678119f: 0.38268343237f; }
typedef float c2 __attribute__((ext_vector_type(2)));
__device__ __forceinline__ c2 bx(c2 a) { return (c2){a.x, a.x}; }
__device__ __forceinline__ c2 by(c2 a) { return (c2){a.y, a.y}; }
template <int A, bool INV>
__device__ __forceinline__ void fft_pass(cf* Xc, int s, int tid) {
    c2* X = (c2*)Xc;
    constexpr int R = 1 << A;
    const int hl = FM >> (s + A);
    for (int sub = tid; sub < FM / R; sub += NT) {
        const int lo = sub & (hl - 1), hi = sub / hl;
        const int base = hi * (hl * R) + lo;
        c2 v[R];
        const int pbase = fphys(base);
#define FOFF(m_) (hl >= 8 ? (m_) * (hl + (hl >> 3)) : ((m_) * hl + (((m_) * hl) >> 3)))
#pragma unroll
        for (int m = 0; m < R; ++m) v[m] = X[pbase + FOFF(m)];
        float sn, cs;
        int lo_ = lo; asm volatile("" : "+v"(lo_));
        __sincosf(-6.283185307179586f * (float)lo_ / (float)(hl * R), &sn, &cs);
        c2 w[A];
        w[0] = (c2){cs, sn};
#pragma unroll
        for (int t = 1; t < A; ++t) { const c2 q = w[t - 1]; w[t] = bx(q) * q + by(q) * (c2){-q.y, q.x}; }
#pragma unroll
        for (int tt = 0; tt < A; ++tt) {
            const int t = INV ? A - 1 - tt : tt;
            const int hm = 1 << (A - 1 - t);
            c2 ta[R / 2], tb[R / 2];
#pragma unroll
            for (int jm = 0; jm < R / 2; ++jm) {
                if (jm >= hm) continue;
                const int n16 = (jm << t) * (16 / R);
                const float c = c16(n16), sg = s16(n16);
                const c2 q = w[t];
                const c2 tw = (c2){c * q.x + sg * q.y, c * q.y - sg * q.x};
                if (!INV) { ta[jm] = tw; tb[jm] = (c2){-tw.y, tw.x}; }
                else { ta[jm] = (c2){tw.x, -tw.y}; tb[jm] = (c2){tw.y, tw.x}; }
            }
#pragma unroll
            for (int m = 0; m < R; ++m) {
                if (m & hm) continue;
                const int jm = m & (hm - 1);
                const c2 a = v[m], b = v[m + hm];
                if (!INV) { const c2 d = a - b; v[m] = a + b; v[m + hm] = bx(d) * ta[jm] + by(d) * tb[jm]; }
                else { const c2 e = bx(b) * ta[jm] + by(b) * tb[jm]; v[m] = a + e; v[m + hm] = a - e; }
            }
        }
#pragma unroll
        for (int m = 0; m < R; ++m) X[pbase + FOFF(m)] = v[m];
#undef FOFF
    }
}
__device__ __forceinline__ int brev13(int k) { return (int)(__brev((unsigned)k) >> 19); }
__device__ __forceinline__ void spec_mul(cf* Z, const cf* G, int tid) {
    for (int idx = tid; idx <= FM / 2; idx += NT) {
        const int p = idx < FM / 2 ? 2 * idx : 1;
        const int k = brev13(p), k2 = (FM - k) & (FM - 1);
        const int pa = fphys(p), pb = fphys(brev13(k2));
        const cf a = Z[pa], b = Z[pb], c = G[pa], d = G[pb];
        const cf Ex{0.5f * (a.x + b.x), 0.5f * (a.y - b.y)};
        const cf tx{0.5f * (a.x - b.x), 0.5f * (a.y + b.y)};
        const cf Ox{tx.y, -tx.x};
        const cf Eg{0.5f * (c.x + d.x), 0.5f * (c.y - d.y)};
        const cf tg{0.5f * (c.x - d.x), 0.5f * (c.y + d.y)};
        const cf Og{tg.y, -tg.x};
        float sn, cs;
        __sincosf(-6.283185307179586f * (float)k / (float)FM, &sn, &cs);
        const cf oo = cmul(cmul(Ox, Og), cf{cs, sn});
        const cf ee = cmul(Ex, Eg);
        const cf Ey{ee.x + oo.x, ee.y + oo.y};
        const cf eo = cmul(Ex, Og), oe = cmul(Ox, Eg);
        const cf Oy{eo.x + oe.x, eo.y + oe.y};
        const float sc = 1.0f / (float)FM;
        Z[pa] = cf{(Ey.x - Oy.y) * sc, (Ey.y + Oy.x) * sc};
        if (pb != pa) Z[pb] = cf{(Ey.x + Oy.y) * sc, (-Ey.y + Oy.x) * sc};
    }
}
#define GFI(j) (2 * fphys((j) >> 1) + ((j) & 1))
__device__ __forceinline__ void hy_filter(const Params& p, int c, int o, float* Gf) {
    const int tid = otid();
    const bf16_t* FW = (const bf16_t*)(p.ws + WS_FILT) + (size_t)(o * 2048 + c) * 8192;
    const bf16_t* BW = (const bf16_t*)(p.ws + WS_FILT) + (size_t)(4096 + o * 2048 + c) * 8192;
    const float bias = p.hy_bias[o * 2048 + c];
#pragma unroll
    for (int i = 0; i < 2; ++i) {
        const int t8 = (tid + NT * i) * 8;
        const u32x4 f = *(const u32x4*)(FW + t8), b = *(const u32x4*)(BW + t8);
        const float fv[8] = {blo(f.x), bhi(f.x), blo(f.y), bhi(f.y), blo(f.z), bhi(f.z), blo(f.w), bhi(f.w)};
        const float bv[8] = {blo(b.x), bhi(b.x), blo(b.y), bhi(b.y), blo(b.z), bhi(b.z), blo(b.w), bhi(b.w)};
#pragma unroll
        for (int e = 0; e < 8; ++e) {
            const int t = t8 + e;
            if (t == 0) { Gf[GFI(0)] = fv[0] + bv[0] + bias; Gf[GFI(8192)] = 0.f; }
            else { Gf[GFI(t)] = fv[e]; Gf[GFI(16384 - t)] = bv[e]; }
        }
    }
}
__device__ __forceinline__ void hy_short8(const bf16_t* row, int t8, float w0, float w1, float w2, float* out) {
    const u32x4 w = *(const u32x4*)(row + t8);
    const float prev = t8 > 0 ? bf2f(row[t8 - 1]) : 0.f, next = t8 + 8 < L ? bf2f(row[t8 + 8]) : 0.f;
    const float r[10] = {prev, blo(w.x), bhi(w.x), blo(w.y), bhi(w.y), blo(w.z), bhi(w.z), blo(w.w), bhi(w.w), next};
#pragma unroll
    for (int e = 0; e < 8; ++e) out[e] = r[e] * w0 + r[e + 1] * w1 + r[e + 2] * w2;
}
__device__ __forceinline__ void hy_tw4(int n0, c2* w) {
    float sn, cs; __sincosf(-6.283185307179586f * (float)n0 / (float)FM, &sn, &cs);
    w[0] = (c2){cs, sn};
    const c2 w1 = {0.99999970586f, -7.6699031874e-4f};
#pragma unroll
    for (int j = 1; j < 4; ++j) { const c2 q = w[j - 1]; w[j] = (c2){q.x * w1.x - q.y * w1.y, q.x * w1.y + q.y * w1.x}; }
}
__device__ __forceinline__ void p8_hyena(const Params& p, unsigned char* lds) {
    const int tid = otid();
    cf* Z = (cf*)lds; cf* G = (cf*)(lds + FARR);
    c2* Z2 = (c2*)lds;
    const bf16_t* HYT = (const bf16_t*)(p.ws + WS_HYT);
    bf16_t* HYOT = (bf16_t*)(p.ws + WS_HYOT);
    for (int c = blockIdx.x; c < 2048; c += gridDim.x) {
        const bf16_t* rx1 = HYT + (size_t)c * L; const bf16_t* rx2 = HYT + (size_t)(2048 + c) * L; const bf16_t* rv = HYT + (size_t)(4096 + c) * L;
        const float* cw = p.hy_conv_w;
        const float a0 = cw[c], a1 = cw[6144 + c], a2 = cw[2 * 6144 + c];
        const float b0 = cw[2048 + c], b1 = cw[6144 + 2048 + c], b2 = cw[2 * 6144 + 2048 + c];
        const float v0 = cw[4096 + c], v1 = cw[6144 + 4096 + c], v2 = cw[2 * 6144 + 4096 + c];
        __syncthreads();
#pragma unroll
        for (int i = 0; i < 2; ++i) {
            const int t8 = (tid + NT * i) * 8, n0 = t8 >> 1;
            float z[8]; hy_short8(rv, t8, v0, v1, v2, z);
            c2 w[4]; hy_tw4(n0, w);
#pragma unroll
            for (int j = 0; j < 4; ++j) { const c2 a = {z[2 * j], z[2 * j + 1]}; Z2[fphys(n0 + j)] = a; Z2[fphys(n0 + j + FM / 2)] = (c2){a.x * w[j].x - a.y * w[j].y, a.x * w[j].y + a.y * w[j].x}; }
        }
        for (int o = 0; o < 2; ++o) {
            hy_filter(p, c, o, (float*)G);
            __syncthreads();
            fft_pass<4, false>(Z, 1, tid); asm volatile("" ::: "memory"); __builtin_amdgcn_sched_barrier(0); fft_pass<4, false>(G, 0, tid); __syncthreads();
            fft_pass<4, false>(Z, 5, tid); asm volatile("" ::: "memory"); __builtin_amdgcn_sched_barrier(0); fft_pass<3, false>(G, 4, tid); __syncthreads();
            fft_pass<4, false>(Z, 9, tid); asm volatile("" ::: "memory"); __builtin_amdgcn_sched_barrier(0); fft_pass<3, false>(G, 7, tid); __syncthreads();
            fft_pass<3, false>(G, 10, tid); __syncthreads();
            spec_mul(Z, G, tid); __syncthreads();
            fft_pass<4, true>(Z, 9, tid); __syncthreads();
            fft_pass<4, true>(Z, 5, tid); __syncthreads();
            fft_pass<4, true>(Z, 1, tid); __syncthreads();
#pragma unroll
            for (int i = 0; i < 2; ++i) {
                const int t8 = (tid + NT * i) * 8, n0 = t8 >> 1;
                float x[8];
                if (o == 0) hy_short8(rx1, t8, a0, a1, a2, x); else hy_short8(rx2, t8, b0, b1, b2, x);
                c2 w[4]; hy_tw4(n0, w);
                unsigned ww[4];
#pragma unroll
                for (int j = 0; j < 4; ++j) {
                    const c2 lo = Z2[fphys(n0 + j)], hi = Z2[fphys(n0 + j + FM / 2)];
                    const c2 y = {lo.x + hi.x * w[j].x + hi.y * w[j].y, lo.y + hi.y * w[j].x - hi.x * w[j].y};
                    const c2 r = {y.x * x[2 * j], y.y * x[2 * j + 1]};
                    if (o == 0) { Z2[fphys(n0 + j)] = r; Z2[fphys(n0 + j + FM / 2)] = (c2){r.x * w[j].x - r.y * w[j].y, r.x * w[j].y + r.y * w[j].x}; }
                    else ww[j] = pk2(r.x, r.y);
                }
                if (o == 1) { u32x4 wv4; wv4.x = ww[0]; wv4.y = ww[1]; wv4.z = ww[2]; wv4.w = ww[3]; *(u32x4*)(HYOT + (size_t)c * L + t8) = wv4; }
            }
        }
    }
    __syncthreads();
}

__device__ __forceinline__ void p9_transpose(const Params& p, unsigned char* lds) {
    const int tid = otid();
    bf16_t* T = (bf16_t*)lds;
    const bf16_t* S = (const bf16_t*)(p.ws + WS_HYOT); bf16_t* O = (bf16_t*)(p.ws + WS_HYO);
    for (int tix = blockIdx.x; tix < 32 * 128; tix += gridDim.x) {
        const int ct = tix >> 7, tt = tix & 127;
        __syncthreads();
        { const int r = tid >> 3, c8 = tid & 7; const u32x4 w = *(const u32x4*)(S + (size_t)(ct * 64 + r) * L + tt * 64 + c8 * 8);
          unsigned* d = (unsigned*)(T + r * 66 + c8 * 8); d[0] = w.x; d[1] = w.y; d[2] = w.z; d[3] = w.w; }
        __syncthreads();
        { const int t = tid >> 3, c8 = tid & 7; u32x4 w;
          w.x = (unsigned)T[(c8 * 8 + 0) * 66 + t] | ((unsigned)T[(c8 * 8 + 1) * 66 + t] << 16); w.y = (unsigned)T[(c8 * 8 + 2) * 66 + t] | ((unsigned)T[(c8 * 8 + 3) * 66 + t] << 16);
          w.z = (unsigned)T[(c8 * 8 + 4) * 66 + t] | ((unsigned)T[(c8 * 8 + 5) * 66 + t] << 16); w.w = (unsigned)T[(c8 * 8 + 6) * 66 + t] | ((unsigned)T[(c8 * 8 + 7) * 66 + t] << 16);
          *(u32x4*)(O + (size_t)(tt * 64 + t) * D + ct * 64 + c8 * 8) = w; }
    }
    __syncthreads();
}
__device__ __forceinline__ void p12_tables(const Params& p) {
    const int tid = otid(), lane = tid & 63, wv = tid >> 6;
    for (int row = blockIdx.x * 8 + wv; row < 2 * 16384; row += gridDim.x * 8) {
        const bool second = row >= 16384; const int r = second ? row - 16384 : row;
        const float* src = (second ? p.peer_v : p.peer_u) + (size_t)r * D;
        f32x4 v[2][4]; float am = 0.f;
#pragma unroll
        for (int i = 0; i < 2; ++i)
#pragma unroll
            for (int j = 0; j < 4; ++j) { v[i][j] = *(const f32x4*)(src + 16 * (lane + 64 * i) + 4 * j);
                am = fmaxf(am, fmaxf(fmaxf(fabsf(v[i][j][0]), fabsf(v[i][j][1])), fmaxf(fabsf(v[i][j][2]), fabsf(v[i][j][3])))); }
#pragma unroll
        for (int o = 32; o >= 1; o >>= 1) am = fmaxf(am, __shfl_xor(am, o));
        const float inv = am > 0.f ? 440.0f / am : 0.f;
        unsigned char* dst = p.ws + (second ? WS_PV : WS_PU) + (size_t)r * D;
#pragma unroll
        for (int i = 0; i < 2; ++i) {
            u32x4 w;
#pragma unroll
            for (int j = 0; j < 4; ++j) { int x = 0;
                x = __builtin_amdgcn_cvt_pk_fp8_f32(v[i][j][0] * inv, v[i][j][1] * inv, x, false);
                x = __builtin_amdgcn_cvt_pk_fp8_f32(v[i][j][2] * inv, v[i][j][3] * inv, x, true);
                w[j] = (unsigned)x; }
            *(u32x4*)(dst + 16 * (lane + 64 * i)) = w;
        }
        if (lane == 0) ((float*)(p.ws + (second ? WS_PSV : WS_PSU)))[r] = am > 0.f ? am / 440.0f : 0.f;
    }
    for (int i = blockIdx.x * NT + tid; i < 8 * 2 * 128 * 128 / 2; i += gridDim.x * NT) ((unsigned*)(p.ws + WS_KEYB))[i] = pk2(p.peer_keys[2 * i], p.peer_keys[2 * i + 1]);
}
typedef float f32x2 __attribute__((ext_vector_type(2)));
#define CVT2(w_, hi_) __builtin_amdgcn_cvt_pk_f32_fp8((int)(w_), (hi_))
__device__ __forceinline__ f32x2 dot16_fp8(u32x4 w8, const f32x2* tv, f32x2 s) {
    s += CVT2(w8.x, false) * tv[0]; s += CVT2(w8.x, true) * tv[1]; s += CVT2(w8.y, false) * tv[2]; s += CVT2(w8.y, true) * tv[3];
    s += CVT2(w8.z, false) * tv[4]; s += CVT2(w8.z, true) * tv[5]; s += CVT2(w8.w, false) * tv[6]; s += CVT2(w8.w, true) * tv[7];
    return s;
}
__device__ __forceinline__ void axpy16_fp8(u32x4 w8, f32x2 act2, f32x2* ao) {
    ao[0] += act2 * CVT2(w8.x, false); ao[1] += act2 * CVT2(w8.x, true); ao[2] += act2 * CVT2(w8.y, false); ao[3] += act2 * CVT2(w8.y, true);
    ao[4] += act2 * CVT2(w8.z, false); ao[5] += act2 * CVT2(w8.z, true); ao[6] += act2 * CVT2(w8.w, false); ao[7] += act2 * CVT2(w8.w, true);
}
__device__ __forceinline__ f32x2 gelu_pk(f32x2 v) {
    const f32x2 av = __builtin_elementwise_abs(v), d = av * 0.2316418882f + 1.0f;
    f32x2 t; t.x = __builtin_amdgcn_rcpf(d.x); t.y = __builtin_amdgcn_rcpf(d.y);
    f32x2 q = t * 0.5307027145f + (-0.7265760135f); q = q * t + 0.7107068705f; q = q * t + (-0.142248368f); q = q * t + 0.127414796f; q = q * t;
    const f32x2 s = (v * v) * (-0.72134752044f);
    f32x2 e; e.x = __builtin_amdgcn_exp2f(s.x); e.y = __builtin_amdgcn_exp2f(s.y);
    const f32x2 m = v * (q * e), r = v - m;
    f32x2 o; o.x = v.x < 0.f ? m.x : r.x; o.y = v.y < 0.f ? m.y : r.y; return o;
}
struct ExGroup { u32x4 uw[GX][2], vw[GX][2]; float gg[GX], su[GX], sv[GX]; };

__device__ __forceinline__ void wave_argmax(float& bv, int& bi) {
#pragma unroll
    for (int o = 32; o >= 1; o >>= 1) {
        const float ov = __shfl_xor(bv, o); const int oi = __shfl_xor(bi, o);
        if (ov > bv || (ov == bv && oi < bi)) { bv = ov; bi = oi; }
    }
}
__device__ __forceinline__ void top16_128(float v0, float v1, int lane, float& outS, int& outI) {
    outS = 0.f; outI = 0;
#pragma unroll 1
    for (int it = 0; it < 16; ++it) {
        const bool u1 = v1 > v0; float bv = u1 ? v1 : v0; int bi = u1 ? lane + 64 : lane;
        wave_argmax(bv, bi);
        if (lane == it) { outS = bv; outI = bi; }
        if (bi == lane) v0 = -3.0e38f; else if (bi == lane + 64) v1 = -3.0e38f;
    }
}
__device__ __forceinline__ void p14_peer(const Params& p, unsigned char* lds) {
    const int tid = otid(), lane = tid & 63, wv = tid >> 6, fr = lane & 15, fq = lane >> 4;
    const bf16_t* QP = (const bf16_t*)(p.ws + WS_QP);
    const bf16_t* VL = (const bf16_t*)(p.ws + WS_VL);
    const float* HLAT = (const float*)(p.ws + WS_HLAT);
    const float* MOD = (const float*)(p.ws + WS_MOD);
    float* Sc = (float*)lds;
    int* eS = (int*)(lds + 2 * 32 * 2 * 132 * 4);
    float* gS = (float*)(eS + 32 * 128);
    float* tS = gS + 32 * 128;
    int* tI = (int*)(tS + 32 * 2 * 16);
    float* cSw = (float*)(tI + 32 * 2 * 16);
    float* lSw = cSw + 8 * 64;
    const bf16_t* KEYB = (const bf16_t*)(p.ws + WS_KEYB);
    int ca = 0, cb = 0;
    { int rem = lane; for (ca = 0; ca < 16; ++ca) { const int cnt = 16 / (ca + 1); if (rem < cnt) break; rem -= cnt; } cb = rem; if (lane >= 50) { ca = 0; cb = 0; } }
    for (int u = blockIdx.x; u < L / 32; u += gridDim.x) {
        const int t0 = u * 32;
        const int rt = wv & 1;
        int fq8o = fq * 8; asm volatile("" : "+v"(fq8o));
        bf16x8 af[2][4];
#define SC_LOAD(hh_) do { _Pragma("unroll") for (int pp = 0; pp < 2; ++pp) _Pragma("unroll") for (int kk = 0; kk < 4; ++kk) \
            af[pp][kk] = *(const bf16x8*)(QP + (size_t)(t0 + rt * 16 + fr) * D + (hh_) * 256 + pp * 128 + kk * 32 + fq8o); } while (0)
        SC_LOAD(0);
#pragma unroll 1
        for (int h = 0; h < 8; ++h) {
            float* ScH = Sc + (h & 1) * (32 * 2 * 132);
            {
                bf16x8 bfr[2][2][4];
#pragma unroll
                for (int pp = 0; pp < 2; ++pp)
#pragma unroll
                    for (int kk = 0; kk < 4; ++kk)
#pragma unroll
                        for (int t2 = 0; t2 < 2; ++t2) bfr[pp][t2][kk] = *(const bf16x8*)(KEYB + ((size_t)(h * 2 + pp) * 128 + ((wv >> 1) * 2 + t2) * 16 + fr) * 128 + kk * 32 + fq8o);
#pragma unroll
                for (int pp = 0; pp < 2; ++pp)
#pragma unroll
                    for (int t2 = 0; t2 < 2; ++t2) {
                        const int kt = (wv >> 1) * 2 + t2;
                        f32x4 acc = {0.f, 0.f, 0.f, 0.f};
#pragma unroll
                        for (int kk = 0; kk < 4; ++kk) acc = mfma16(af[pp][kk], bfr[pp][t2][kk], acc);
#pragma unroll
                        for (int j = 0; j < 4; ++j) ScH[((rt * 16 + fq * 4 + j) * 2 + pp) * 132 + kt * 16 + fr] = __uint_as_float((__float_as_uint(acc[j]) & ~127u) | (unsigned)(127 - (kt * 16 + fr)));
                    }
                if (h + 1 < 8) SC_LOAD(h + 1);
            }
            __syncthreads();
            {
                unsigned k0[8], k1[8], T[8];
#pragma unroll
                for (int q = 0; q < 8; ++q) {
                    const float* row = ScH + ((wv * 4 + (q >> 1)) * 2 + (q & 1)) * 132;
                    const unsigned b0 = __float_as_uint(row[lane]), b1 = __float_as_uint(row[lane + 64]);
                    k0[q] = b0 ^ ((b0 >> 31) ? 0xFFFFFFFFu : 0x80000000u); k1[q] = b1 ^ ((b1 >> 31) ? 0xFFFFFFFFu : 0x80000000u);
                    T[q] = 0u;
                }
#pragma unroll 1
                for (int bit = 31; bit >= 7; --bit) {
#pragma unroll
                    for (int q = 0; q < 8; ++q) {
                        const unsigned cand = T[q] | (1u << bit);
                        const int cnt = __popcll(__ballot(k0[q] >= cand)) + __popcll(__ballot(k1[q] >= cand));
                        T[q] = cnt >= 16 ? cand : T[q];
                    }
                }
#pragma unroll
                for (int q = 0; q < 8; ++q) {
                    const int tk = wv * 4 + (q >> 1), pp = q & 1;
                    const float* row = ScH + (tk * 2 + pp) * 132;
                    const bool s0 = k0[q] >= T[q], s1 = k1[q] >= T[q];
                    const unsigned long long m0 = __ballot(s0), m1 = __ballot(s1);
                    const int p0 = __builtin_amdgcn_mbcnt_hi((unsigned)(m0 >> 32), __builtin_amdgcn_mbcnt_lo((unsigned)m0, 0u));
                    const int p1 = __popcll(m0) + __builtin_amdgcn_mbcnt_hi((unsigned)(m1 >> 32), __builtin_amdgcn_mbcnt_lo((unsigned)m1, 0u));
                    float* lS = lSw + (wv * 8 + q) * 32; int* lI = (int*)(lS + 16);
                    if (s0 && p0 < 16) { lS[p0] = row[lane]; lI[p0] = lane; }
                    if (s1 && p1 < 16) { lS[p1] = row[lane + 64]; lI[p1] = lane + 64; }
                }
                __builtin_amdgcn_wave_barrier();
#pragma unroll
                for (int rd = 0; rd < 2; ++rd) {
                    const int q = rd * 4 + (lane >> 4), j = lane & 15, tk = wv * 4 + (q >> 1), pp = q & 1;
                    const float* lS = lSw + (wv * 8 + q) * 32; const int* lI = (const int*)(lS + 16);
                    const float my = lS[j]; const int mi = lI[j];
                    int rk = 0;
#pragma unroll
                    for (int j4 = 0; j4 < 4; ++j4) { const f32x4 x = *(const f32x4*)(lS + j4 * 4);
#pragma unroll
                        for (int e = 0; e < 4; ++e) rk += (x[e] > my) ? 1 : 0; }
                    tS[(tk * 2 + pp) * 16 + rk] = my; tI[(tk * 2 + pp) * 16 + rk] = mi;
                }
            }
            __builtin_amdgcn_wave_barrier();
            {
                float cval[4]; unsigned ck[4], T[4];
#pragma unroll
                for (int q = 0; q < 4; ++q) {
                    const int tk = wv * 4 + q;
                    cval[q] = tS[(tk * 2) * 16 + ca] + tS[(tk * 2 + 1) * 16 + cb];
                    const unsigned bb = __float_as_uint(cval[q]);
                    ck[q] = lane < 50 ? (bb ^ ((bb >> 31) ? 0xFFFFFFFFu : 0x80000000u)) : 0u;
                    T[q] = 0u;
                }
#pragma unroll 1
                for (int bit = 31; bit >= 7; --bit) {
#pragma unroll
                    for (int q = 0; q < 4; ++q) {
                        const unsigned cand = T[q] | (1u << bit);
                        const int cnt = __popcll(__ballot(ck[q] >= cand));
                        T[q] = cnt >= 16 ? cand : T[q];
                    }
                }
                float ex[4]; int slot[4]; bool okw[4];
#pragma unroll
                for (int q = 0; q < 4; ++q) {
                    const int tk = wv * 4 + q;
                    const bool win = ck[q] >= T[q] && lane < 50;
                    const unsigned long long m = __ballot(win);
                    slot[q] = __builtin_amdgcn_mbcnt_hi((unsigned)(m >> 32), __builtin_amdgcn_mbcnt_lo((unsigned)m, 0u));
                    okw[q] = win && slot[q] < 16;
                    const float mx = tS[(tk * 2) * 16] + tS[(tk * 2 + 1) * 16];
                    ex[q] = okw[q] ? __expf(cval[q] - mx) : 0.f;
                }
                float sm[4];
#pragma unroll
                for (int q = 0; q < 4; ++q) sm[q] = ex[q];
#pragma unroll
                for (int o = 32; o >= 1; o >>= 1) {
#pragma unroll
                    for (int q = 0; q < 4; ++q) sm[q] += __shfl_xor(sm[q], o);
                }
#pragma unroll
                for (int q = 0; q < 4; ++q) {
                    const int tk = wv * 4 + q;
                    if (okw[q]) { eS[tk * 128 + h * 16 + slot[q]] = tI[(tk * 2) * 16 + ca] * 128 + tI[(tk * 2 + 1) * 16 + cb]; gS[tk * 128 + h * 16 + slot[q]] = ex[q] / sm[q]; }
                }
            }
        }
        __syncthreads();
        const unsigned char* PU8 = p.ws + WS_PU; const unsigned char* PV8 = p.ws + WS_PV;
        const float* PSU = (const float*)(p.ws + WS_PSU); const float* PSV = (const float*)(p.ws + WS_PSV);
#pragma unroll 1
#define GQ 4
        for (int q = 0; q < 4; ++q) {
            const int tk = wv * 4 + q, t = t0 + tk;
            f32x2 tv[16];
#pragma unroll
            for (int i = 0; i < 2; ++i)
#pragma unroll
                for (int hh = 0; hh < 2; ++hh) { const u32x4 w = *(const u32x4*)(VL + (size_t)t * D + 16 * (lane + 64 * i) + 8 * hh);
                    tv[i * 8 + hh * 4 + 0] = (f32x2){blo(w.x), bhi(w.x)}; tv[i * 8 + hh * 4 + 1] = (f32x2){blo(w.y), bhi(w.y)}; tv[i * 8 + hh * 4 + 2] = (f32x2){blo(w.z), bhi(w.z)}; tv[i * 8 + hh * 4 + 3] = (f32x2){blo(w.w), bhi(w.w)}; }
            struct UG { u32x4 uw[GQ][2]; float su[GQ], sv[GQ]; };
#define EXU_LOAD(G_, k0_) do { _Pragma("unroll") for (int x = 0; x < GQ; ++x) { const int e = eS[tk * 128 + (k0_) + x]; G_.su[x] = PSU[e]; G_.sv[x] = PSV[e]; \
        _Pragma("unroll") for (int i = 0; i < 2; ++i) G_.uw[x][i] = *(const u32x4*)(PU8 + (size_t)e * D + 16 * (lane + 64 * i)); } } while (0)
#define EXU_COMPUTE(G_, k0_) do { float d[GQ]; \
        _Pragma("unroll") for (int x = 0; x < GQ; ++x) { f32x2 s2 = {0.f, 0.f}; s2 = dot16_fp8(G_.uw[x][0], tv, s2); s2 = dot16_fp8(G_.uw[x][1], tv + 8, s2); d[x] = s2.x + s2.y; } \
        _Pragma("unroll") for (int o = 32; o >= 1; o >>= 1) { _Pragma("unroll") for (int x = 0; x < GQ; ++x) d[x] += __shfl_xor(d[x], o); } \
        const f32x2 g01 = gelu_pk((f32x2){d[0] * G_.su[0], d[1] * G_.su[1]}), g23 = gelu_pk((f32x2){d[2] * G_.su[2], d[3] * G_.su[3]}); \
        const float av = lane == 0 ? g01.x * G_.sv[0] : lane == 1 ? g01.y * G_.sv[1] : lane == 2 ? g23.x * G_.sv[2] : g23.y * G_.sv[3]; \
        if (lane < GQ) gS[tk * 128 + (k0_) + lane] *= av; } while (0)
            UG ga, gb;
            EXU_LOAD(ga, 0);
#pragma unroll 1
            for (int k0 = 0; k0 < 128; k0 += 2 * GQ) {
                EXU_LOAD(gb, k0 + GQ);
                EXU_COMPUTE(ga, k0);
                if (k0 + 2 * GQ < 128) EXU_LOAD(ga, k0 + 2 * GQ);
                EXU_COMPUTE(gb, k0 + GQ);
            }
        }
        __builtin_amdgcn_wave_barrier();
        for (int q = 0; q < 4; ++q) {
            const int tk = wv * 4 + q, t = t0 + tk;
            f32x2 ao[16];
#pragma unroll
            for (int i = 0; i < 16; ++i) ao[i] = (f32x2){0.f, 0.f};
            struct VG { u32x4 vw[GQ][2]; float act[GQ]; };
#define EXV_LOAD(G_, k0_) do { _Pragma("unroll") for (int x = 0; x < GQ; ++x) { const int e = eS[tk * 128 + (k0_) + x]; G_.act[x] = gS[tk * 128 + (k0_) + x]; \
        _Pragma("unroll") for (int i = 0; i < 2; ++i) G_.vw[x][i] = *(const u32x4*)(PV8 + (size_t)e * D + 16 * (lane + 64 * i)); } } while (0)
#define EXV_COMPUTE(G_) do { _Pragma("unroll") for (int x = 0; x < GQ; ++x) { const f32x2 act2 = {G_.act[x], G_.act[x]}; axpy16_fp8(G_.vw[x][0], act2, ao); axpy16_fp8(G_.vw[x][1], act2, ao + 8); } } while (0)
            VG ga, gb;
            EXV_LOAD(ga, 0);
#pragma unroll 1
            for (int k0 = 0; k0 < 128; k0 += 2 * GQ) {
                EXV_LOAD(gb, k0 + GQ);
                EXV_COMPUTE(ga);
                if (k0 + 2 * GQ < 128) EXV_LOAD(ga, k0 + 2 * GQ);
                EXV_COMPUTE(gb);
            }
            int lane16 = 16 * lane; asm volatile("" : "+v"(lane16));
            float ss = 0.f;
#pragma unroll
            for (int i = 0; i < 2; ++i)
#pragma unroll
                for (int j = 0; j < 4; ++j) {
                    const int c = lane16 + 1024 * i + 4 * j;
                    const f32x4 hv = *(const f32x4*)(HLAT + (size_t)t * D + c), g2 = *(const f32x4*)(MOD + 5 * D + c);
                    f32x2 v0 = ao[i * 8 + j * 2], v1 = ao[i * 8 + j * 2 + 1];
                    v0.x = hv[0] + g2[0] * v0.x; v0.y = hv[1] + g2[1] * v0.y; v1.x = hv[2] + g2[2] * v1.x; v1.y = hv[3] + g2[3] * v1.y;
                    ao[i * 8 + j * 2] = v0; ao[i * 8 + j * 2 + 1] = v1; ss += v0.x * v0.x + v0.y * v0.y + v1.x * v1.x + v1.y * v1.y;
                }
            ss = wave_sum(ss);
            const float rinv = rsqrtf(ss * (1.0f / D) + EPS);
#pragma unroll
            for (int i = 0; i < 2; ++i)
#pragma unroll
                for (int j = 0; j < 4; ++j) {
                    const int c = lane16 + 1024 * i + 4 * j;
                    const f32x4 fg = *(const f32x4*)(p.final_g + c);
                    const f32x2 v0 = ao[i * 8 + j * 2], v1 = ao[i * 8 + j * 2 + 1];
                    f32x4 o; o[0] = v0.x * rinv * fg[0]; o[1] = v0.y * rinv * fg[1]; o[2] = v1.x * rinv * fg[2]; o[3] = v1.y * rinv * fg[3];
                    *(f32x4*)(p.out + (size_t)t * D + c) = o;
                }
        }
    }
    __syncthreads();
}

__global__ void __launch_bounds__(NT, 2) fwd_megakernel(Params p) {
    extern __shared__ __attribute__((aligned(16))) unsigned char lds[];
    cg::grid_group grid = cg::this_grid();
    PG8_LAS unsigned char* ldsg = (PG8_LAS unsigned char*)lds;
    const int G = gridDim.x, bx = blockIdx.x;
    volatile LAS unsigned* xst = (volatile LAS unsigned*)((LAS unsigned char*)lds + LDS_MAIN);
    if (threadIdx.x < 4) xst[threadIdx.x] = 0u;
    __syncthreads();
    XcdBarrier bar = xcd_barrier_post((unsigned*)(p.ws + WS_BAR), xst);
#define W16(off) ((bf16_t*)(p.ws + (off)))
#define PHASE(k, body) do { body; if ((REPEAT_MASK >> (k)) & 1) { xcd_barrier(bar); body; } } while (0)
    PHASE(0, p0_gemv_hdn(p, lds));
    if (p.ph_lo < 0) grid.sync();
    xcd_barrier(bar);
    PHASE(1, ({ p1_filters(p); p1_weights(p, lds); }));
    xcd_barrier(bar);
    PHASE(2, p_rownorm<0>(p));
    xcd_barrier(bar);
    PHASE(3, ({ p3_side_tasks(p, lds);
                { pg8::Gemm g{W16(WS_WHY), W16(WS_U), 6144, L, D}; pg8::StaticOrder S; S.init(6144, L, G, bx); pg8::EpiBf16 E{W16(WS_HYT), L}; pg8::gemm_phase<pg8::EpiBf16, pg8::StaticOrder>(ldsg, g, S, E); }
                  { pg8::Gemm g{W16(WS_U), W16(WS_WREST), L, C_GT, D}; pg8::StaticOrder S; S.init(L, C_GT, G, bx); pg8::EpiBf16 E{W16(WS_P1), NREST}; pg8::gemm_phase<pg8::EpiBf16, pg8::StaticOrder>(ldsg, g, S, E); } }));
    xcd_barrier(bar);
    PHASE(8, p8_hyena(p, lds));
    PHASE(4, p4_conv_gates(p, lds));
    xcd_barrier(bar);
    PHASE(5, p5_local_states(p, lds));
    xcd_barrier(bar);
    PHASE(6, p6_scan(p));
    xcd_barrier(bar);
    PHASE(7, ({ if (bx & 1) p12_tables(p); p7_mlstm_out(p, lds); if (!(bx & 1)) p12_tables(p); }));
    PHASE(9, p9_transpose(p, lds));
    xcd_barrier(bar);
    PHASE(10, ({ { pg8::Gemm g{W16(WS_HML), W16(WS_WPM), L, D, D}; pg8::StaticOrder S; S.init(L, D, G, bx); pg8::EpiGate1 E{(float*)(p.ws + WS_Y1), D, W16(WS_P1) + C_BGM, NREST}; pg8::gemm_phase<pg8::EpiGate1, pg8::StaticOrder>(ldsg, g, S, E); }
                   { pg8::Gemm g{W16(WS_HYO), W16(WS_WPH), L, D, D}; pg8::StaticOrder S; S.init(L, D, G, bx); pg8::EpiGate2 E{(const float*)(p.ws + WS_Y1), W16(WS_Y), D, W16(WS_P1) + C_BGH, NREST}; pg8::gemm_phase<pg8::EpiGate2, pg8::StaticOrder>(ldsg, g, S, E); } }));
    xcd_barrier(bar);
    PHASE(11, ({ pg8::Gemm g{W16(WS_Y), W16(WS_WO), L, D, D}; pg8::StaticOrder S; S.init(L, D, G, bx); pg8::EpiRes E{p.x, (float*)(p.ws + WS_HLAT), D, (const float*)(p.ws + WS_MOD) + 2 * D}; pg8::gemm_phase<pg8::EpiRes, pg8::StaticOrder>(ldsg, g, S, E); }));
    xcd_barrier(bar);
    PHASE(12, p_rownorm<1>(p));
    xcd_barrier(bar);
    PHASE(13, ({ pg8::Gemm g{W16(WS_VL), W16(WS_WQ), L, D, D}; pg8::StaticOrder S; S.init(L, D, G, bx); pg8::EpiBf16 E{W16(WS_QP), D}; pg8::gemm_phase<pg8::EpiBf16, pg8::StaticOrder>(ldsg, g, S, E); }));
    xcd_barrier(bar);
    PHASE(14, p14_peer(p, lds));
}
constexpr int NPHASE = 15;

extern "C" void kernel_launch(void* const* d_in, const int* in_sizes, int n_in, void* d_out, int out_size, void* d_ws, size_t ws_size, hipStream_t stream) {
    static int grid = 0;
    if (grid == 0) {
        if (n_in != 28 || ws_size < WS_END) { fprintf(stderr, "kernel_launch: n_in %d ws_size %zu (need %zu)\n", n_in, ws_size, (size_t)WS_END); grid = -1; return; }
        int dev = 0, cus = 0, per_cu = 0;
        hipGetDevice(&dev);
        hipDeviceGetAttribute(&cus, hipDeviceAttributeMultiprocessorCount, dev);
        if (hipFuncSetAttribute((const void*)fwd_megakernel, hipFuncAttributeMaxDynamicSharedMemorySize, LDS_BYTES) != hipSuccess) { fprintf(stderr, "kernel_launch: hipFuncSetAttribute failed\n"); grid = -1; return; }
        if (hipOccupancyMaxActiveBlocksPerMultiprocessor(&per_cu, (const void*)fwd_megakernel, NT, LDS_BYTES) != hipSuccess || per_cu < 1) { fprintf(stderr, "kernel_launch: occupancy query says %d\n", per_cu); (void)hipGetLastError(); grid = -1; return; }
        grid = cus;
    }
    if (grid < 0) return;
    Params p{};
    const float** pf = (const float**)&p;
    for (int i = 0; i < 28; ++i) pf[i] = (const float*)d_in[i];
    p.out = (float*)d_out; p.ws = (unsigned char*)d_ws;
    p.ph_lo = 0; p.ph_hi = NPHASE;
    if (hipMemsetAsync((char*)d_ws + WS_BAR, 0, (size_t)XCD_BAR_WORDS * 4, stream) != hipSuccess) { fprintf(stderr, "kernel_launch: memset failed\n"); return; }
    void* args[] = {&p};
    hipError_t e = hipLaunchCooperativeKernel((void*)fwd_megakernel, dim3(grid), dim3(NT), args, LDS_BYTES, stream);
    if (e != hipSuccess) fprintf(stderr, "cooperative launch failed: %s (grid %d)\n", hipGetErrorString(e), grid);
}
```

```cpp
#include <hip/hip_runtime.h>
#include <hip/hip_cooperative_groups.h>
#include <cstdio>
#include <cstdint>
namespace cg = cooperative_groups;

namespace pg8 {
#define PG8_LAS __attribute__((address_space(3)))
typedef unsigned short bf16_t;
typedef short bf16x8 __attribute__((ext_vector_type(8)));
typedef float f32x4 __attribute__((ext_vector_type(4)));
typedef unsigned u32x4 __attribute__((ext_vector_type(4)));
typedef unsigned u32x2 __attribute__((ext_vector_type(2)));
constexpr int BM = 256, BK = 64, HALF = 128, HTB = HALF * BK * 2, STAGE_BYTES = 8 * HTB, NXCD = 8, WGM = 8;
__host__ __device__ __forceinline__ int lds_byte(int r, int c) { const int st = (r >> 4) * 2 + (c >> 5), rr = r & 15, cc = c & 31, ob = rr * 64 + cc * 2; return st * 1024 + (ob ^ (((ob >> 9) & 1) << 5)); }
__host__ __device__ __forceinline__ void stage_rc(int b, int& R, int& C) { const int st = b / 1024, sb = b % 1024, swz = sb ^ (((sb >> 9) & 1) << 5); R = (st >> 1) * 16 + swz / 64; C = (st & 1) * 32 + (swz % 64) / 2; }
__host__ __device__ __forceinline__ int perm32(int rho) { const int n = rho >> 4, i = rho & 15; return 8 * (i >> 2) + 4 * n + (i & 3); }

struct Unit { int pm, pn; };
struct Gemm { const bf16_t* A; const bf16_t* Bt; int M, N, K; };

struct StaticOrder {
    int nM, nN, nwg, G, c;
    __host__ __device__ void init(int M, int N, int G_, int c_) { nM = M / BM; nN = N / BM; nwg = nM * nN; G = G_; c = c_; }
    __host__ __device__ bool next(int i, Unit& u) const {
        const long L = (long)i * G + c; if (L >= nwg) return false;
        int wgid = (int)L; { const int q = nwg / NXCD, r = nwg % NXCD, xcd = wgid % NXCD, off = wgid / NXCD; wgid = (xcd < r ? xcd * (q + 1) : r * (q + 1) + (xcd - r) * q) + off; }
        const int nig = WGM * nN, gid = wgid / nig, fm = gid * WGM, gsz = (nM - fm) < WGM ? (nM - fm) : WGM;
        u.pm = fm + ((wgid % nig) % gsz); u.pn = (wgid % nig) / gsz; return true;
    }
    __device__ __forceinline__ void a_ready(const Unit&) const {}
    __device__ __forceinline__ void done(const Unit&) const {}
};
__device__ __forceinline__ unsigned cvt_pk_bf16(float lo, float hi) { unsigned r; asm volatile("v_cvt_pk_bf16_f32 %0, %1, %2" : "=v"(r) : "v"(lo), "v"(hi)); return r; }
__device__ __forceinline__ float bflo(unsigned w) { return __uint_as_float(w << 16); }
__device__ __forceinline__ float bfhi(unsigned w) { return __uint_as_float(w & 0xffff0000u); }
__device__ __forceinline__ float sigm(float x) { return 1.0f / (1.0f + __expf(-x)); }
struct EpiBf16 {
    static constexpr bool PERM = true, AFTER_DRAIN = false;
    bf16_t* O; int ldc;
    __device__ __forceinline__ void operator()(const f32x4 (&acc)[2][2][4][2], const Unit& u, int wr, int wc, int fr, int fq) const {
        const int row0 = u.pm * BM + wr * 64 + fr, col0 = u.pn * BM + wc * 32 + 8 * fq;
#pragma unroll
        for (int ai = 0; ai < 2; ++ai)
#pragma unroll
            for (int m = 0; m < 4; ++m) { bf16_t* rowp = O + (size_t)(row0 + ai * HALF + m * 16) * ldc + col0;
#pragma unroll
                for (int bj = 0; bj < 2; ++bj) { const f32x4 v0 = acc[ai][bj][m][0], v1 = acc[ai][bj][m][1];
                    u32x4 w; w.x = cvt_pk_bf16(v0[0], v0[1]); w.y = cvt_pk_bf16(v0[2], v0[3]); w.z = cvt_pk_bf16(v1[0], v1[1]); w.w = cvt_pk_bf16(v1[2], v1[3]);
                    *(u32x4*)(rowp + bj * HALF) = w; } }
    }
};
struct EpiGate1 {
    static constexpr bool PERM = false, AFTER_DRAIN = false;
    float* Y1; int ldc; const bf16_t* bg; int ldg;
    __device__ __forceinline__ void operator()(const f32x4 (&acc)[2][2][4][2], const Unit& u, int wr, int wc, int fr, int fq) const {
        const int row0 = u.pm * BM + wr * 64 + fr, col0 = u.pn * BM + wc * 32 + 4 * fq;
#pragma unroll
        for (int ai = 0; ai < 2; ++ai)
#pragma unroll
            for (int m = 0; m < 4; ++m) { const size_t r = (size_t)(row0 + ai * HALF + m * 16);
#pragma unroll
                for (int bj = 0; bj < 2; ++bj)
#pragma unroll
                    for (int n = 0; n < 2; ++n) { const int c = col0 + bj * HALF + n * 16; const u32x2 gw = *(const u32x2*)(bg + r * ldg + c); const f32x4 a = acc[ai][bj][m][n];
                        f32x4 o; o[0] = sigm(bflo(gw.x)) * a[0]; o[1] = sigm(bfhi(gw.x)) * a[1]; o[2] = sigm(bflo(gw.y)) * a[2]; o[3] = sigm(bfhi(gw.y)) * a[3];
                        *(f32x4*)(Y1 + r * ldc + c) = o; } }
    }
};
struct EpiGate2 {
    static constexpr bool PERM = false, AFTER_DRAIN = false;
    const float* Y1; bf16_t* Y; int ldc; const bf16_t* bg; int ldg;
    __device__ __forceinline__ void operator()(const f32x4 (&acc)[2][2][4][2], const Unit& u, int wr, int wc, int fr, int fq) const {
        const int row0 = u.pm * BM + wr * 64 + fr, col0 = u.pn * BM + wc * 32 + 4 * fq;
#pragma unroll
        for (int ai = 0; ai < 2; ++ai)
#pragma unroll
            for (int m = 0; m < 4; ++m) { const size_t r = (size_t)(row0 + ai * HALF + m * 16);
#pragma unroll
                for (int bj = 0; bj < 2; ++bj)
#pragma unroll
                    for (int n = 0; n < 2; ++n) { const int c = col0 + bj * HALF + n * 16; const u32x2 gw = *(const u32x2*)(bg + r * ldg + c); const f32x4 a = acc[ai][bj][m][n];
                        const f32x4 y1 = *(const f32x4*)(Y1 + r * ldc + c);
                        u32x2 w; w.x = cvt_pk_bf16(y1[0] + sigm(bflo(gw.x)) * a[0], y1[1] + sigm(bfhi(gw.x)) * a[1]); w.y = cvt_pk_bf16(y1[2] + sigm(bflo(gw.y)) * a[2], y1[3] + sigm(bfhi(gw.y)) * a[3]);
                        *(u32x2*)(Y + r * ldc + c) = w; } }
    }
};
struct EpiRes {
    static constexpr bool PERM = false, AFTER_DRAIN = false;
    const float* X; float* H; int ldc; const float* g1;
    __device__ __forceinline__ void operator()(const f32x4 (&acc)[2][2][4][2], const Unit& u, int wr, int wc, int fr, int fq) const {
        const int row0 = u.pm * BM + wr * 64 + fr, col0 = u.pn * BM + wc * 32 + 4 * fq;
#pragma unroll
        for (int ai = 0; ai < 2; ++ai)
#pragma unroll
            for (int m = 0; m < 4; ++m) { const size_t r = (size_t)(row0 + ai * HALF + m * 16);
#pragma unroll
                for (int bj = 0; bj < 2; ++bj)
#pragma unroll
                    for (int n = 0; n < 2; ++n) { const int c = col0 + bj * HALF + n * 16; const f32x4 gv = *(const f32x4*)(g1 + c); const f32x4 xv = *(const f32x4*)(X + r * ldc + c);
                        *(f32x4*)(H + r * ldc + c) = xv + gv * acc[ai][bj][m][n]; } }
    }
};
template <class Epi, class Sched>
__device__ __forceinline__ void gemm_phase(PG8_LAS unsigned char* lds, const Gemm g, const Sched& S, const Epi& E) {
    const int tid = threadIdx.x, wid = __builtin_amdgcn_readfirstlane(tid >> 6), lane = tid & 63, wr = wid >> 2, wc = wid & 3, fr = lane & 15, fq = lane >> 4;
    const int K = g.K, nt = K / BK;
    unsigned voffA[2], voffB[2];
#pragma unroll
    for (int i = 0; i < 2; ++i) { int R, C; stage_rc(tid * 16 + i * 8192, R, C); const int Rb = Epi::PERM ? ((R & ~31) + perm32(R & 31)) : R;
        voffA[i] = (unsigned)(R * K + C) * 2u; voffB[i] = (unsigned)(Rb * K + C) * 2u; }
    const size_t kstep = (size_t)(BK * 2);
    const size_t hstep = (size_t)HALF * K * 2;
    const size_t tstep = 2 * hstep;
    const unsigned ldsw = (unsigned)wid * 1024u;
    const int aoff = lds_byte(wr * 64 + fr, fq * 8), boff = lds_byte(wc * 32 + fr, fq * 8);
#define PG8_SA(b, h) (((b) * 2 + (h)) * HTB)
#define PG8_SB(b, h) ((4 + (b) * 2 + (h)) * HTB)
#define PG8_STAGE(bufoff, gbase, voff) do { _Pragma("unroll") for (int _i = 0; _i < 2; ++_i) \
        __builtin_amdgcn_global_load_lds((const unsigned*)((const char*)(gbase) + (voff)[_i]), (PG8_LAS unsigned*)(lds + (bufoff) + ldsw + _i * 8192), 16, 0, 0); } while (0)
#define PG8_LDA(dst, b, h) do { _Pragma("unroll") for (int m = 0; m < 4; ++m) _Pragma("unroll") for (int k = 0; k < 2; ++k) dst[m][k] = *(const PG8_LAS bf16x8*)(lds + PG8_SA(b, h) + aoff + m * 2048 + k * 1024); } while (0)
#define PG8_LDB(dst, b, h) do { _Pragma("unroll") for (int n = 0; n < 2; ++n) _Pragma("unroll") for (int k = 0; k < 2; ++k) dst[n][k] = *(const PG8_LAS bf16x8*)(lds + PG8_SB(b, h) + boff + n * 2048 + k * 1024); } while (0)
#define PG8_MMA(ai, bj, At, Bt) do { __builtin_amdgcn_s_setprio(1); _Pragma("unroll") for (int m = 0; m < 4; ++m) _Pragma("unroll") for (int n = 0; n < 2; ++n) _Pragma("unroll") for (int k = 0; k < 2; ++k) \
        acc[ai][bj][m][n] = __builtin_amdgcn_mfma_f32_16x16x32_bf16(Bt[n][k], At[m][k], acc[ai][bj][m][n], 0, 0, 0); __builtin_amdgcn_s_setprio(0); } while (0)
#define PG8_WAIT_V(n) asm volatile("s_waitcnt vmcnt(" #n ")" ::: "memory")
#define PG8_WAIT_L(n) asm volatile("s_waitcnt lgkmcnt(" #n ")" ::: "memory")
#define PG8_BAR __builtin_amdgcn_s_barrier()
#define PG8_SCHED __builtin_amdgcn_sched_barrier(0)
    Unit cur, nxt; int ui = 0;
    if (!S.next(0, cur)) return;
    f32x4 acc[2][2][4][2];
#pragma unroll
    for (int a = 0; a < 2; ++a)
#pragma unroll
        for (int b = 0; b < 2; ++b)
#pragma unroll
            for (int m = 0; m < 4; ++m)
#pragma unroll
                for (int n = 0; n < 2; ++n) acc[a][b][m][n] = (f32x4){0.f, 0.f, 0.f, 0.f};
    bf16x8 At[4][2], B0[2][2], B1[2][2];
    const char* cA = (const char*)g.A + (size_t)cur.pm * tstep; const char* cB = (const char*)g.Bt + (size_t)cur.pn * tstep;
    S.a_ready(cur);
    PG8_STAGE(PG8_SB(0, 0), cB, voffB); PG8_STAGE(PG8_SA(0, 0), cA, voffA); PG8_STAGE(PG8_SB(0, 1), cB + hstep, voffB); PG8_STAGE(PG8_SA(0, 1), cA + hstep, voffA);
    if (wr == 1) PG8_BAR;
    PG8_WAIT_V(4); PG8_BAR;
    PG8_STAGE(PG8_SB(1, 0), cB + kstep, voffB); PG8_STAGE(PG8_SA(1, 0), cA + kstep, voffA); PG8_STAGE(PG8_SB(1, 1), cB + hstep + kstep, voffB);
    PG8_WAIT_V(6); PG8_BAR;
    for (;;) {
        const bool has_next = S.next(ui + 1, nxt);
        const char* nA = has_next ? (const char*)g.A + (size_t)nxt.pm * tstep : cA; const char* nB = has_next ? (const char*)g.Bt + (size_t)nxt.pn * tstep : cB;
        for (int t = 0; t < nt; t += 2) {
            const bool last = (t == nt - 2);
            const char* a1 = cA + (size_t)(t + 1) * kstep;
            const char* a2 = last ? nA : cA + (size_t)(t + 2) * kstep; const char* b2 = last ? nB : cB + (size_t)(t + 2) * kstep;
            const char* a3 = a2 + kstep; const char* b3 = b2 + kstep;
            if (last && has_next) S.a_ready(nxt);
            PG8_LDB(B0, 0, 0); PG8_SCHED; PG8_LDA(At, 0, 0); PG8_STAGE(PG8_SA(1, 1), a1 + hstep, voffA);
            PG8_WAIT_L(8); PG8_BAR; PG8_WAIT_L(0); PG8_MMA(0, 0, At, B0); PG8_BAR; PG8_SCHED;
            PG8_LDB(B1, 0, 1); PG8_STAGE(PG8_SB(0, 0), b2, voffB);
            PG8_BAR; PG8_WAIT_L(0); PG8_MMA(0, 1, At, B1); PG8_BAR;
            PG8_LDA(At, 0, 1); PG8_STAGE(PG8_SA(0, 0), a2, voffA);
            PG8_BAR; PG8_WAIT_L(0); PG8_MMA(1, 0, At, B0); PG8_BAR; PG8_SCHED;
            PG8_STAGE(PG8_SB(0, 1), b2 + hstep, voffB);
            PG8_WAIT_V(6); PG8_BAR; PG8_MMA(1, 1, At, B1); PG8_BAR;
            PG8_LDB(B0, 1, 0); PG8_SCHED; PG8_LDA(At, 1, 0); PG8_STAGE(PG8_SA(0, 1), a2 + hstep, voffA);
            PG8_WAIT_L(8); PG8_BAR; PG8_WAIT_L(0); PG8_MMA(0, 0, At, B0); PG8_BAR; PG8_SCHED;
            PG8_LDB(B1, 1, 1); PG8_STAGE(PG8_SB(1, 0), b3, voffB);
            PG8_BAR; PG8_WAIT_L(0); PG8_MMA(0, 1, At, B1); PG8_BAR;
            PG8_LDA(At, 1, 1); PG8_STAGE(PG8_SA(1, 0), a3, voffA);
            PG8_BAR; PG8_WAIT_L(0); PG8_MMA(1, 0, At, B0); PG8_BAR; PG8_SCHED;
            PG8_STAGE(PG8_SB(1, 1), b3 + hstep, voffB);
            PG8_WAIT_V(6); PG8_BAR; PG8_MMA(1, 1, At, B1); PG8_BAR;
        }
        if constexpr (!Epi::AFTER_DRAIN) { E(acc, cur, wr, wc, fr, fq); S.done(cur); }
        if (!has_next) break;
#pragma unroll
        for (int a = 0; a < 2; ++a)
#pragma unroll
            for (int b = 0; b < 2; ++b)
#pragma unroll
                for (int m = 0; m < 4; ++m)
#pragma unroll
                    for (int n = 0; n < 2; ++n) acc[a][b][m][n] = (f32x4){0.f, 0.f, 0.f, 0.f};
        cur = nxt; cA = nA; cB = nB; ++ui;
    }
    PG8_WAIT_V(0);
    if (wr == 0) PG8_BAR;
    PG8_BAR;
    if constexpr (Epi::AFTER_DRAIN) { E.fused(acc, cur, wr, wc, fr, fq, lds, wid, lane); S.done(cur); }
#undef PG8_SA
#undef PG8_SB
#undef PG8_STAGE
#undef PG8_LDA
#undef PG8_LDB
#undef PG8_MMA
#undef PG8_WAIT_V
#undef PG8_WAIT_L
#undef PG8_BAR
#undef PG8_SCHED
}
}

#define XB_TMO      128
#define XB_XCNT(j)  (256  + 64 * (j))
#define XB_XSUB(j)  (1280 + 64 * (j))
#define XB_XGEN(j)  (2304 + 64 * (j))
#define XB_TOP      3328
#define XB_TOPGEN   3392
#define XCD_BAR_WORDS 3456
#define XB_SPIN_CAP (1u << 22)
#define LAS __attribute__((address_space(3)))
__device__ __forceinline__ unsigned xb_ld(unsigned* p)              { return __hip_atomic_load(p, __ATOMIC_RELAXED, __HIP_MEMORY_SCOPE_AGENT); }
__device__ __forceinline__ unsigned xb_add(unsigned* p, unsigned v) { return __hip_atomic_fetch_add(p, v, __ATOMIC_RELAXED, __HIP_MEMORY_SCOPE_AGENT); }
__device__ __forceinline__ unsigned xb_xcc_id() { return (unsigned)__builtin_amdgcn_s_getreg((3 << 11) | 20) & 0xFu; }
#define XB_SPIN(cond, bar) do { unsigned _sp = 0; while (cond) { __builtin_amdgcn_s_sleep(1); \
    if ((++_sp & 255u) == 0u) { if (xb_ld(&(bar)[XB_TMO])) break; if (_sp > XB_SPIN_CAP) { atomicAdd(&(bar)[XB_TMO], 1u); break; } } } } while (0)
struct XcdBarrier { unsigned* bar; unsigned x; volatile LAS unsigned* st; };
__device__ __forceinline__ XcdBarrier xcd_barrier_post(unsigned* bar, volatile LAS unsigned* st) {
    XcdBarrier b; b.bar = bar; b.x = xb_xcc_id(); b.st = st;
    if (threadIdx.x == 0) (void)xb_add(&bar[XB_XCNT(b.x)], 1u);
    return b;
}
__device__ __forceinline__ void xcd_barrier_complete(unsigned* bar, unsigned x, unsigned& nloc, unsigned& nx) {
    const unsigned G = gridDim.x * gridDim.y * gridDim.z;
    unsigned sum, cnt, mine, sp = 0u;
    for (;;) {
        sum = 0u; cnt = 0u; mine = 0u;
#pragma unroll
        for (unsigned j = 0; j < 16; ++j) { const unsigned c = xb_ld(&bar[XB_XCNT(j)]); sum += c; cnt += (c > 0u) ? 1u : 0u; mine = (j == x) ? c : mine; }
        if (sum == G) break;
        __builtin_amdgcn_s_sleep(1);
        if ((++sp & 255u) == 0u) { if (xb_ld(&bar[XB_TMO])) break; if (sp > XB_SPIN_CAP) { atomicAdd(&bar[XB_TMO], 1u); break; } }
    }
    nloc = mine > 0u ? mine : 1u; nx = cnt > 0u ? cnt : 1u;
}
__device__ __forceinline__ void xcd_barrier(const XcdBarrier& b) {
    asm volatile("s_waitcnt vmcnt(0)" ::: "memory");
    __syncthreads();
    if (threadIdx.x == 0) {
        unsigned* bar = b.bar;
        __builtin_amdgcn_s_waitcnt(0);
        unsigned nloc = b.st[0], nx = b.st[1];
        if (nloc == 0u) { xcd_barrier_complete(bar, b.x, nloc, nx); b.st[0] = nloc; b.st[1] = nx; }
        const unsigned old = xb_add(&bar[XB_XSUB(b.x)], 1u);
        const unsigned gen = old / nloc;
        if (old + 1u == (gen + 1u) * nloc) {
            __builtin_amdgcn_fence(__ATOMIC_RELEASE, "agent");
            asm volatile("s_waitcnt vmcnt(0)" ::: "memory");
            const unsigned og = xb_add(&bar[XB_TOP], 1u);
            const unsigned tg = og / nx;
            if (og + 1u == (tg + 1u) * nx) xb_add(&bar[XB_TOPGEN], 1u);
            else XB_SPIN(xb_ld(&bar[XB_TOPGEN]) == tg, bar);
            __builtin_amdgcn_fence(__ATOMIC_ACQUIRE, "agent");
            xb_add(&bar[XB_XGEN(b.x)], 1u);
            asm volatile("s_waitcnt vmcnt(0)" ::: "memory");
        } else {
            XB_SPIN(xb_ld(&bar[XB_XGEN(b.x)]) == gen, bar);
            __builtin_amdgcn_fence(__ATOMIC_ACQUIRE, "agent");
            asm volatile("s_waitcnt vmcnt(0)" ::: "memory");
        }
    }
    __syncthreads();
}

typedef unsigned short bf16_t;
typedef short bf16x8 __attribute__((ext_vector_type(8)));
typedef float f32x4 __attribute__((ext_vector_type(4)));
typedef unsigned u32x4 __attribute__((ext_vector_type(4)));
typedef unsigned u32x2 __attribute__((ext_vector_type(2)));
typedef short s16x4 __attribute__((ext_vector_type(4)));
constexpr int NT = 512;
constexpr int D = 2048, L = 8192, LC = 256, LT = L + LC;
constexpr int INW = 16416;
constexpr int NREST = 10496;
constexpr int C_QK = 0, C_V = 2048, C_O = 4096, C_BGM = 6144, C_BGH = 8192, C_GT = 10240;
constexpr int NCH = 16, NCK = 33, TC = 256;
constexpr float EPS = 1e-6f;
constexpr int LDS_MAIN = 144 * 1024;
constexpr int LDS_BYTES = LDS_MAIN + 16;
#ifndef REPEAT_MASK
#define REPEAT_MASK 0
#endif
constexpr int KS = 32;
#ifndef GXV
#define GXV 2
#endif
constexpr int GX = GXV;
static_assert(GX == 2 || GX == 1, "EX_COMPUTE evaluates the gelu of exactly two experts per group");

constexpr size_t al(size_t x) { return (x + 255) & ~(size_t)255; }
constexpr size_t WS_MODP = 0;
constexpr size_t WS_MOD = WS_MODP + al((size_t)KS * 2 * 12288 * 4);
constexpr size_t WS_HDN = WS_MOD + al((size_t)2 * 12288 * 4);
constexpr size_t WS_WPM = WS_HDN + al((size_t)L * 64 * 2);
constexpr size_t WS_WPH = WS_WPM + al((size_t)D * D * 2);
constexpr size_t WS_WO = WS_WPH + al((size_t)D * D * 2);
constexpr size_t WS_WQ = WS_WO + al((size_t)D * D * 2);
constexpr size_t WS_A = WS_WQ + al((size_t)D * D * 2);
constexpr size_t WS_WREST = WS_A;
constexpr size_t WS_WHY = WS_WREST + al((size_t)NREST * D * 2);
constexpr size_t WS_A_END = WS_WHY + al((size_t)6144 * D * 2);
constexpr size_t WS_HML = WS_A;
constexpr size_t WS_HYOT = WS_HML + al((size_t)L * D * 2);
static_assert(WS_HYOT + (size_t)L * D * 2 <= WS_A_END, "region A overlay");
constexpr size_t WS_U = WS_A_END;
constexpr size_t WS_U_END = WS_U + al((size_t)LT * D * 2);
constexpr size_t WS_SPRE = WS_U;
constexpr size_t WS_VL = WS_U;
static_assert((size_t)NCH * NCK * 256 * 128 * 2 <= WS_U_END - WS_U, "SPRE overlay");
constexpr size_t WS_P1 = WS_U_END;
constexpr size_t WS_P1_END = WS_P1 + al((size_t)LT * NREST * 2);
constexpr size_t WS_HYT = WS_P1_END;
constexpr size_t WS_HYT_END = WS_HYT + al((size_t)6144 * L * 2);
constexpr size_t WS_HLAT = WS_HYT;
static_assert((size_t)L * D * 4 <= WS_HYT_END - WS_HYT, "HLAT overlay");
constexpr size_t WS_QK = WS_HYT_END;
constexpr size_t WS_QP = WS_QK;
constexpr size_t WS_G = WS_QK + al((size_t)LT * D * 2);
constexpr size_t WS_GB = WS_G, WS_GA = WS_GB + al((size_t)NCH * LT * 4), WS_GM = WS_GA + al((size_t)NCH * LT * 4);
constexpr size_t WS_SLOC = WS_GM + al((size_t)NCH * LT * 4);
constexpr size_t WS_SLOC_END = WS_SLOC + al((size_t)NCH * NCK * 256 * 128 * 4);
constexpr size_t WS_Y1 = WS_SLOC;
constexpr size_t WS_NLOC = WS_SLOC_END;
constexpr size_t WS_NPRE = WS_NLOC + al((size_t)NCH * NCK * 128 * 4);
constexpr size_t WS_MLOC = WS_NPRE + al((size_t)NCH * NCK * 128 * 4);
constexpr size_t WS_MPRE = WS_MLOC + al((size_t)NCH * NCK * 4);
constexpr size_t WS_HYO = WS_MPRE + al((size_t)NCH * NCK * 4);
constexpr size_t WS_Y = WS_HYO + al((size_t)L * D * 2);
constexpr size_t WS_YEND = WS_Y + al((size_t)L * D * 2);
constexpr size_t WS_FILT = WS_SLOC;
static_assert(WS_FILT + (size_t)8192 * 8192 * 2 <= WS_YEND, "FILT overlay");
constexpr size_t WS_BAR = WS_YEND;
constexpr size_t WS_KEYB = WS_BAR + al((size_t)XCD_BAR_WORDS * 4);
constexpr size_t WS_PU = WS_KEYB + al((size_t)8 * 2 * 128 * 128 * 2);
constexpr size_t WS_PSU = WS_PU + al((size_t)16384 * D);
constexpr size_t WS_PSV = WS_PSU + al((size_t)16384 * 4);
constexpr size_t WS_END = WS_PSV + al((size_t)16384 * 4);
constexpr size_t WS_PV = WS_HYT + al((size_t)L * D * 4);
static_assert(WS_PV + (size_t)16384 * D <= WS_HYT_END, "V table tail overlay");
static_assert(WS_END <= (size_t)643323008, "workspace map must stay within sum(inputs) bytes, the guaranteed minimum");

struct Params {
    const float *x, *c, *ctx, *c_ctx, *w_mod, *b_mod, *norm1_g, *norm2_g, *final_g, *w_in, *ml_conv_w, *ml_gate_b, *ml_norm_g, *hy_conv_w,
        *hy_w1, *hy_b1, *hy_w2, *hy_b2, *hy_w3, *hy_freq, *hy_bias, *w_proj_ml, *w_proj_hy, *w_out, *peer_wq, *peer_keys, *peer_u, *peer_v;
    float* out; unsigned char* ws;
    int ph_lo, ph_hi;
};

__device__ __forceinline__ int otid() { int t = threadIdx.x; asm volatile("" : "+v"(t)); return t; }
__device__ __forceinline__ bf16_t f2bf(float f) { unsigned u = __float_as_uint(f); u += 0x7FFFu + ((u >> 16) & 1u); return (bf16_t)(u >> 16); }
__device__ __forceinline__ float bf2f(bf16_t b) { return __uint_as_float(((unsigned)b) << 16); }
__device__ __forceinline__ unsigned pk2(float lo, float hi) { return (unsigned)f2bf(lo) | ((unsigned)f2bf(hi) << 16); }
__device__ __forceinline__ float blo(unsigned w) { return __uint_as_float(w << 16); }
__device__ __forceinline__ float bhi(unsigned w) { return __uint_as_float(w & 0xffff0000u); }
__device__ __forceinline__ float sigmoidf_(float x) { return 1.0f / (1.0f + __expf(-x)); }
__device__ __forceinline__ float siluf_(float x) { return x / (1.0f + __expf(-x)); }
__device__ __forceinline__ float wave_sum(float v) {
#pragma unroll
    for (int o = 32; o >= 1; o >>= 1) v += __shfl_xor(v, o);
    return v;
}
__device__ __forceinline__ f32x4 mfma16(bf16x8 a, bf16x8 b, f32x4 c) { return __builtin_amdgcn_mfma_f32_16x16x32_bf16(a, b, c, 0, 0, 0); }

__device__ __forceinline__ void p0_gemv_hdn(const Params& p, unsigned char* lds) {
    const int tid = otid();
    float* MODP = (float*)(p.ws + WS_MODP);
    const int gthreads = gridDim.x * NT;
    float* sl = (float*)lds;
    for (int k = tid; k < D; k += NT) { sl[k] = siluf_(p.c[k]); sl[D + k] = siluf_(p.c_ctx[k]); }
    __syncthreads();
    for (int item = blockIdx.x * NT + tid; item < KS * 3072; item += gthreads) {
        const int ks = item / 3072, cg4 = item % 3072;
        f32x4 a0 = {0.f, 0.f, 0.f, 0.f}, a1 = {0.f, 0.f, 0.f, 0.f};
        const int k0 = ks * (D / KS);
        for (int k = k0; k < k0 + D / KS; ++k) {
            const f32x4 w = *(const f32x4*)(p.w_mod + (size_t)k * 12288 + cg4 * 4);
            const float s0 = sl[k], s1 = sl[D + k];
            a0 += w * s0; a1 += w * s1;
        }
        *(f32x4*)(MODP + ((size_t)(ks * 2 + 0) * 12288) + cg4 * 4) = a0;
        *(f32x4*)(MODP + ((size_t)(ks * 2 + 1) * 12288) + cg4 * 4) = a1;
    }
    __syncthreads();
    bf16_t* HDN = (bf16_t*)(p.ws + WS_HDN);
    float* h1s = (float*)lds;
    const int tt = tid >> 6, j = tid & 63;
    for (int u = blockIdx.x; u < L / 8; u += gridDim.x) {
        const int t = u * 8 + tt;
        const float tn = (float)t / (float)L;
        float s = p.hy_b1[j] + tn * p.hy_w1[j];
#pragma unroll
        for (int b = 0; b < 8; ++b) {
            const float band = 1e-4f + (7.0f - 1e-4f) * (float)b / 7.0f;
            const float ang = (6.283185307179586f / (float)L) * (float)t * band;
            float sn, cs; __sincosf(ang, &sn, &cs);
            s += cs * p.hy_w1[(1 + b) * 64 + j] - sn * p.hy_w1[(9 + b) * 64 + j];
        }
        const float fr = p.hy_freq[j];
        __syncthreads();
        h1s[tt * 64 + j] = __sinf(fr * s);
        __syncthreads();
        float s2 = p.hy_b2[j];
        for (int i = 0; i < 64; ++i) s2 += h1s[tt * 64 + i] * p.hy_w2[i * 64 + j];
        HDN[(size_t)t * 64 + j] = f2bf(__sinf(fr * s2));
    }
    __syncthreads();
}

struct TGroup { const float* src; int ld, k0, n0; bf16_t* dst; };
__device__ __forceinline__ TGroup p1_group(const Params& p, int tix) {
    const int NG_IN = 256 * 8, NG_SQ = 32 * 8;
    TGroup g;
    if (tix < NG_IN) {
        const int ct = tix >> 3, kg = tix & 7;
        const int dc = ct * 64;
        g.src = p.w_in; g.ld = INW; g.k0 = kg * 256;
        if (dc < 6144) { g.n0 = dc; g.dst = (bf16_t*)(p.ws + WS_WREST) + (size_t)dc * D; }
        else if (dc < 10240) { g.n0 = 12320 + (dc - 6144); g.dst = (bf16_t*)(p.ws + WS_WREST) + (size_t)dc * D; }
        else { g.n0 = 6176 + (dc - 10240); g.dst = (bf16_t*)(p.ws + WS_WHY) + (size_t)(dc - 10240) * D; }
    } else {
        const int q = tix - NG_IN, wsel = q / NG_SQ, r = q % NG_SQ, ct = r >> 3, kg = r & 7;
        g.src = wsel == 0 ? p.w_proj_ml : wsel == 1 ? p.w_proj_hy : wsel == 2 ? p.w_out : p.peer_wq; g.ld = D; g.k0 = kg * 256; g.n0 = ct * 64;
        g.dst = (bf16_t*)(p.ws + (wsel == 0 ? WS_WPM : wsel == 1 ? WS_WPH : wsel == 2 ? WS_WO : WS_WQ)) + (size_t)ct * 64 * D;
    }
    return g;
}
__device__ __forceinline__ void tg_load(const TGroup& g, int tid, f32x4 (&v)[4][2]) {
#pragma unroll
    for (int q = 0; q < 4; ++q)
#pragma unroll
        for (int i = 0; i < 2; ++i) { const int r = (tid >> 4) + 32 * i, c4 = tid & 15; v[q][i] = *(const f32x4*)(g.src + (size_t)(g.k0 + q * 64 + r) * g.ld + g.n0 + c4 * 4); }
}
__device__ __forceinline__ void tg_store(const TGroup& g, int tid, const f32x4 (&v)[4][2], unsigned char* lds) {
    float* T = (float*)lds;
#pragma unroll
    for (int q = 0; q < 4; ++q)
#pragma unroll
        for (int i = 0; i < 2; ++i) { const int r = (tid >> 4) + 32 * i, c4 = tid & 15; float* t = T + q * 64 * 65 + r * 65 + c4 * 4;
            t[0] = v[q][i][0]; t[1] = v[q][i][1]; t[2] = v[q][i][2]; t[3] = v[q][i][3]; }
    __syncthreads();
    {
        const int n = tid >> 3, k8 = tid & 7;
#pragma unroll
        for (int q = 0; q < 4; ++q) {
            const float* t = T + q * 64 * 65;
            u32x4 w;
            w.x = pk2(t[(k8 * 8 + 0) * 65 + n], t[(k8 * 8 + 1) * 65 + n]); w.y = pk2(t[(k8 * 8 + 2) * 65 + n], t[(k8 * 8 + 3) * 65 + n]);
            w.z = pk2(t[(k8 * 8 + 4) * 65 + n], t[(k8 * 8 + 5) * 65 + n]); w.w = pk2(t[(k8 * 8 + 6) * 65 + n], t[(k8 * 8 + 7) * 65 + n]);
            *(u32x4*)(g.dst + (size_t)n * D + g.k0 + q * 64 + k8 * 8) = w;
        }
    }
    __syncthreads();
}
__device__ __forceinline__ void p1_weights(const Params& p, unsigned char* lds) {
    const int tid = otid();
    if (blockIdx.x < 48) {
        const int n = blockIdx.x * NT + tid; const int v = n / 12288, nn = n % 12288;
        const float* MODP = (const float*)(p.ws + WS_MODP);
        float s = p.b_mod[nn];
        for (int ks = 0; ks < KS; ++ks) s += MODP[(size_t)(ks * 2 + v) * 12288 + nn];
        ((float*)(p.ws + WS_MOD))[n] = s;
    }
    const int NG = 256 * 8 + 4 * 32 * 8;
    {
        f32x4 va[4][2], vb[4][2];
        int tix = blockIdx.x;
        TGroup ga = p1_group(p, tix < NG ? tix : 0), gb = ga;
        if (tix < NG) tg_load(ga, tid, va);
#pragma unroll 1
        for (; tix < NG; tix += 2 * gridDim.x) {
            const int t2 = tix + gridDim.x, t3 = tix + 2 * gridDim.x;
            if (t2 < NG) { gb = p1_group(p, t2); tg_load(gb, tid, vb); }
            tg_store(ga, tid, va, lds);
            if (t3 < NG) { ga = p1_group(p, t3); tg_load(ga, tid, va); }
            if (t2 < NG) tg_store(gb, tid, vb, lds);
        }
    }
    for (int item = blockIdx.x * NT + tid; item < 32 * D; item += gridDim.x * NT) {
        const int k = item >> 5, j = item & 31;
        ((bf16_t*)(p.ws + WS_WREST))[(size_t)(C_GT + j) * D + k] = f2bf(p.w_in[(size_t)k * INW + 6144 + j]);
    }
}

__device__ __forceinline__ void p1_filters(const Params& p) {
    const int tid = otid(), lane = tid & 63, wv = tid >> 6, fr = lane & 15, fq = lane >> 4;
    const bf16_t* HDN = (const bf16_t*)(p.ws + WS_HDN);
    bf16_t* FILT = (bf16_t*)(p.ws + WS_FILT);
    const float dmin = -3.0701134573253944f, dmax = -15.350567286626972f;
    for (int task = blockIdx.x * 8 + wv; task < 512 * 8; task += gridDim.x * 8) {
        const int cgp = task >> 3, tpart = task & 7;
        const int col = cgp * 16 + fr;
        bf16x8 bw[2];
#pragma unroll
        for (int kk = 0; kk < 2; ++kk)
#pragma unroll
            for (int e = 0; e < 8; ++e) bw[kk][e] = (short)f2bf(p.hy_w3[(size_t)(kk * 32 + fq * 8 + e) * 8192 + col]);
        const float delta = fabsf(dmin + (dmax - dmin) * (float)(col & 2047) / 2047.0f);
#pragma unroll 1
        for (int tt0 = 0; tt0 < 64; tt0 += 8) {
            bf16x8 af[8][2];
#pragma unroll
            for (int q = 0; q < 8; ++q)
#pragma unroll
                for (int kk = 0; kk < 2; ++kk) af[q][kk] = *(const bf16x8*)(HDN + (size_t)((tpart * 64 + tt0 + q) * 16 + fr) * 64 + kk * 32 + fq * 8);
#pragma unroll
            for (int q = 0; q < 8; ++q) {
                f32x4 acc = {0.f, 0.f, 0.f, 0.f};
                acc = mfma16(af[q][0], bw[0], acc); acc = mfma16(af[q][1], bw[1], acc);
                const int t0 = (tpart * 64 + tt0 + q) * 16 + fq * 4;
                float v[4];
#pragma unroll
                for (int j = 0; j < 4; ++j) v[j] = acc[j] * (__expf(-((float)(t0 + j) / (float)L) * delta) + 0.05f);
                u32x2 w; w.x = pk2(v[0], v[1]); w.y = pk2(v[2], v[3]);
                *(u32x2*)(FILT + (size_t)col * 8192 + t0) = w;
            }
        }
    }
}

template <int MODE>
__device__ __forceinline__ void p_rownorm(const Params& p) {
    const int tid = otid(), lane = tid & 63, wv = tid >> 6;
    const float* MOD = (const float*)(p.ws + WS_MOD);
    const int nrows = MODE == 0 ? LT : L;
    bf16_t* O = (bf16_t*)(p.ws + (MODE == 0 ? WS_U : WS_VL));
    const float* gn = MODE == 0 ? p.norm1_g : p.norm2_g;
    for (int row = blockIdx.x * 8 + wv; row < nrows; row += gridDim.x * 8) {
        const float* src = MODE == 0 ? (row < L ? p.x + (size_t)row * D : p.ctx + (size_t)(row - L) * D) : (const float*)(p.ws + WS_HLAT) + (size_t)row * D;
        const float* md = MOD + ((MODE == 0 && row >= L) ? 12288 : 0) + (MODE == 0 ? 0 : 3 * D);
        f32x4 v[8]; float ss = 0.f;
#pragma unroll
        for (int i = 0; i < 8; ++i) { v[i] = *(const f32x4*)(src + (lane + 64 * i) * 4); ss += v[i][0] * v[i][0] + v[i][1] * v[i][1] + v[i][2] * v[i][2] + v[i][3] * v[i][3]; }
        ss = wave_sum(ss);
        const float rinv = rsqrtf(ss * (1.0f / D) + EPS);
#pragma unroll
        for (int i = 0; i < 8; ++i) {
            const int c = (lane + 64 * i) * 4;
            const f32x4 g = *(const f32x4*)(gn + c), sh = *(const f32x4*)(md + c), sc = *(const f32x4*)(md + D + c);
            const f32x4 y = v[i] * rinv * g * (sc + 1.0f) + sh;
            u32x2 w; w.x = pk2(y[0], y[1]); w.y = pk2(y[2], y[3]);
            *(u32x2*)(O + (size_t)row * D + c) = w;
        }
    }
}

__device__ __forceinline__ void mini_gemm_task(const bf16_t* A, const bf16_t* Bt, bf16_t* O, unsigned char* lds) {
    const int tid = otid(), lane = tid & 63, wv = tid >> 6, fr = lane & 15, fq = lane >> 4;
    f32x4 acc[4][4];
#pragma unroll
    for (int m = 0; m < 4; ++m)
#pragma unroll
        for (int n = 0; n < 4; ++n) acc[m][n] = (f32x4){0.f, 0.f, 0.f, 0.f};
#pragma unroll 1
    for (int ks = 0; ks < 8; ks += 2) {
        bf16x8 af[2][4], bfr[2][4];
#pragma unroll
        for (int u = 0; u < 2; ++u)
#pragma unroll
            for (int m = 0; m < 4; ++m) { const int k = wv * 256 + (ks + u) * 32 + fq * 8;
                af[u][m] = *(const bf16x8*)(A + (size_t)(m * 16 + fr) * D + k); bfr[u][m] = *(const bf16x8*)(Bt + (size_t)(m * 16 + fr) * D + k); }
#pragma unroll
        for (int u = 0; u < 2; ++u)
#pragma unroll
            for (int m = 0; m < 4; ++m)
#pragma unroll
                for (int n = 0; n < 4; ++n) acc[m][n] = mfma16(af[u][m], bfr[u][n], acc[m][n]);
    }
    float* red = (float*)lds;
    __syncthreads();
#pragma unroll
    for (int m = 0; m < 4; ++m)
#pragma unroll
        for (int n = 0; n < 4; ++n) *(f32x4*)(red + (((size_t)wv * 16 + m * 4 + n) * 64 + lane) * 4) = acc[m][n];
    __syncthreads();
#pragma unroll
    for (int i = 0; i < 2; ++i) {
        const int g = tid + NT * i, tile = g >> 6, ln = g & 63, m = tile >> 2, n = tile & 3;
        f32x4 sum = {0.f, 0.f, 0.f, 0.f};
#pragma unroll
        for (int w = 0; w < 8; ++w) sum += *(const f32x4*)(red + (((size_t)w * 16 + tile) * 64 + ln) * 4);
#pragma unroll
        for (int j = 0; j < 4; ++j) O[(size_t)(m * 16 + (ln >> 4) * 4 + j) * NREST + n * 16 + (ln & 15)] = f2bf(sum[j]);
    }
    __syncthreads();
}
__device__ __forceinline__ void p3_side_tasks(const Params& p, unsigned char* lds) {
    const bf16_t* U = (const bf16_t*)(p.ws + WS_U); const bf16_t* W = (const bf16_t*)(p.ws + WS_WREST); bf16_t* P1 = (bf16_t*)(p.ws + WS_P1);
    for (int task = blockIdx.x; task < 256 + 132; task += gridDim.x) {
        if (task < 256) { const int rb = task >> 6, cb = task & 63;
            mini_gemm_task(U + (size_t)(L + rb * 64) * D, W + (size_t)(cb * 64) * D, P1 + (size_t)(L + rb * 64) * NREST + cb * 64, lds); }
        else { const int rb = task - 256;
            mini_gemm_task(U + (size_t)(rb * 64) * D, W + (size_t)C_GT * D, P1 + (size_t)(rb * 64) * NREST + C_GT, lds); }
    }
}

__device__ __forceinline__ int pos_row(int dir, int pos) {
    return dir == 0 ? (pos < LC ? L + pos : pos - LC) : (pos < LC ? L + (LC - 1 - pos) : (L - 1) - (pos - LC));
}
__device__ __forceinline__ float logsigmoidf_(float x) { return fminf(x, 0.f) - log1pf(__expf(-fabsf(x))); }
__device__ __forceinline__ void p4_conv_gates(const Params& p, unsigned char* lds) {
    const int tid = otid(), lane = tid & 63;
    const bf16_t* P1 = (const bf16_t*)(p.ws + WS_P1);
    bf16_t* QK = (bf16_t*)(p.ws + WS_QK);
    if (blockIdx.x < NCH) {
        const int chain = blockIdx.x, dir = chain >> 3, head = chain & 7, wv = tid >> 6;
        float* GB = (float*)(p.ws + WS_GB) + (size_t)chain * LT; float* GA = (float*)(p.ws + WS_GA) + (size_t)chain * LT; float* GM = (float*)(p.ws + WS_GM) + (size_t)chain * LT;
        const float bi = p.ml_gate_b[(dir * 2) * 8 + head], bfg = p.ml_gate_b[(dir * 2 + 1) * 8 + head];
        const int ci = C_GT + (dir * 2) * 8 + head, cfc = C_GT + (dir * 2 + 1) * 8 + head;
        float* red = (float*)lds;
        constexpr int SEG = 17;
        const int p0 = tid * SEG;
        float gf[SEG], ga[SEG];
        float lsum = 0.f;
#pragma unroll
        for (int i = 0; i < SEG; ++i) {
            const int pos = p0 + i; const bool ok = pos < LT; const int r = pos_row(dir, ok ? pos : 0);
            gf[i] = ok ? logsigmoidf_(bf2f(P1[(size_t)r * NREST + cfc]) + bfg) : 0.f;
            ga[i] = ok ? bf2f(P1[(size_t)r * NREST + ci]) + bi : -1e30f;
            lsum += gf[i];
        }
        float incl = lsum;
#pragma unroll
        for (int o = 1; o < 64; o <<= 1) { const float t = __shfl_up(incl, o); if (lane >= o) incl += t; }
        __syncthreads();
        if (lane == 63) red[wv] = incl;
        __syncthreads();
        float woff = 0.f;
        for (int i = 0; i < wv; ++i) woff += red[i];
        float run = woff + incl - lsum, lmax = -1e30f;
#pragma unroll
        for (int i = 0; i < SEG; ++i) {
            const int pos = p0 + i;
            run += gf[i];
            ga[i] = ga[i] - run;
            if (pos < LT) { GB[pos] = run; GA[pos] = ga[i]; lmax = fmaxf(lmax, ga[i]); }
        }
        float imax = lmax;
#pragma unroll
        for (int o = 1; o < 64; o <<= 1) { const float t = __shfl_up(imax, o); if (lane >= o) imax = fmaxf(imax, t); }
        __syncthreads();
        if (lane == 63) red[wv] = imax;
        __syncthreads();
        float pm = __shfl_up(imax, 1); if (lane == 0) pm = -1e30f;
        for (int i = 0; i < wv; ++i) pm = fmaxf(pm, red[i]);
#pragma unroll
        for (int i = 0; i < SEG; ++i) { const int pos = p0 + i; if (pos < LT) { pm = fmaxf(pm, ga[i]); GM[pos] = pm; } }
        __syncthreads();
    }
    const float qs = 0.08838834764831845f;
    for (int g = blockIdx.x * NT + tid; g < 256 * 64 * 8; g += gridDim.x * NT) {
        const int c8 = (g & 255) * 8, gc = (g >> 8) & 63, seg = g >> 14;
        float w[9][8];
#pragma unroll
        for (int k = 0; k < 9; ++k) { const f32x4 w0 = *(const f32x4*)(p.ml_conv_w + (size_t)k * D + c8), w1 = *(const f32x4*)(p.ml_conv_w + (size_t)k * D + c8 + 4);
            w[k][0] = w0[0]; w[k][1] = w0[1]; w[k][2] = w0[2]; w[k][3] = w0[3]; w[k][4] = w1[0]; w[k][5] = w1[1]; w[k][6] = w1[2]; w[k][7] = w1[3]; }
        const float sc = c8 < 1024 ? qs : 1.0f;
        u32x4 win[3][3];
        const u32x4 zero4 = {0u, 0u, 0u, 0u};
#define CV_LOAD(slot_, r_) do { _Pragma("unroll") for (int dc = 0; dc < 3; ++dc) { const int c2_ = gc + dc - 1; const bool ok_ = (r_) >= 0 && (r_) < 128 && c2_ >= 0 && c2_ < 64; \
            win[slot_][dc] = ok_ ? *(const u32x4*)(P1 + (size_t)((r_) * 64 + c2_) * NREST + C_QK + c8) : zero4; } } while (0)
        const int r0 = seg * 16;
        CV_LOAD(0, r0 - 1); CV_LOAD(1, r0);
#pragma unroll 1
        for (int rr = 0; rr < 16; rr += 3) {
#pragma unroll
            for (int ph = 0; ph < 3; ++ph) {
                const int r = r0 + rr + ph;
                if (rr + ph < 16) {
                    CV_LOAD((ph + 2) % 3, r + 1);
                    float acc[8];
#pragma unroll
                    for (int e = 0; e < 8; ++e) acc[e] = 0.f;
#pragma unroll
                    for (int dr = 0; dr < 3; ++dr)
#pragma unroll
                        for (int dc = 0; dc < 3; ++dc) {
                            const u32x4 v = win[(ph + dr) % 3][dc]; const int k = dr * 3 + dc;
                            acc[0] += blo(v.x) * w[k][0]; acc[1] += bhi(v.x) * w[k][1]; acc[2] += blo(v.y) * w[k][2]; acc[3] += bhi(v.y) * w[k][3];
                            acc[4] += blo(v.z) * w[k][4]; acc[5] += bhi(v.z) * w[k][5]; acc[6] += blo(v.w) * w[k][6]; acc[7] += bhi(v.w) * w[k][7];
                        }
                    u32x4 o;
                    o.x = pk2(siluf_(acc[0]) * sc, siluf_(acc[1]) * sc); o.y = pk2(siluf_(acc[2]) * sc, siluf_(acc[3]) * sc);
                    o.z = pk2(siluf_(acc[4]) * sc, siluf_(acc[5]) * sc); o.w = pk2(siluf_(acc[6]) * sc, siluf_(acc[7]) * sc);
                    *(u32x4*)(QK + (size_t)(r * 64 + gc) * D + c8) = o;
                }
            }
        }
    }
    for (int item = blockIdx.x * NT + tid; item < LC * 256; item += gridDim.x * NT) {
        const int i0 = item >> 8, c8 = (item & 255) * 8;
        float acc[8];
#pragma unroll
        for (int e = 0; e < 8; ++e) acc[e] = 0.f;
#pragma unroll
        for (int dc = 0; dc < 3; ++dc) {
            const int i2 = i0 + dc - 1;
            if (i2 < 0 || i2 >= LC) continue;
            const u32x4 v = *(const u32x4*)(P1 + (size_t)(L + i2) * NREST + C_QK + c8);
            const f32x4 w0 = *(const f32x4*)(p.ml_conv_w + (size_t)(3 + dc) * D + c8), w1 = *(const f32x4*)(p.ml_conv_w + (size_t)(3 + dc) * D + c8 + 4);
            acc[0] += blo(v.x) * w0[0]; acc[1] += bhi(v.x) * w0[1]; acc[2] += blo(v.y) * w0[2]; acc[3] += bhi(v.y) * w0[3];
            acc[4] += blo(v.z) * w1[0]; acc[5] += bhi(v.z) * w1[1]; acc[6] += blo(v.w) * w1[2]; acc[7] += bhi(v.w) * w1[3];
        }
        const float sc = c8 < 1024 ? qs : 1.0f;
        u32x4 w;
        w.x = pk2(siluf_(acc[0]) * sc, siluf_(acc[1]) * sc); w.y = pk2(siluf_(acc[2]) * sc, siluf_(acc[3]) * sc);
        w.z = pk2(siluf_(acc[4]) * sc, siluf_(acc[5]) * sc); w.w = pk2(siluf_(acc[6]) * sc, siluf_(acc[7]) * sc);
        *(u32x4*)(QK + (size_t)(L + i0) * D + c8) = w;
    }
}

__device__ __forceinline__ void p5_local_states(const Params& p, unsigned char* lds) {
    const int tid = otid(), lane = tid & 63, wv = tid >> 6, fr = lane & 15, fq = lane >> 4;
    const bf16_t* P1 = (const bf16_t*)(p.ws + WS_P1);
    const bf16_t* QK = (const bf16_t*)(p.ws + WS_QK);
    bf16_t* Vt = (bf16_t*)lds;
    bf16_t* Kt = (bf16_t*)(lds + 256 * 72 * 2);
    float* red = (float*)(lds + 256 * 72 * 2 + 128 * 72 * 2);
    float* wg = red + 16;
    for (int u0 = blockIdx.x; u0 < NCH * (NCK - 1); u0 += gridDim.x) {
        const int chain = u0 / (NCK - 1), c = u0 % (NCK - 1), dir = chain >> 3, head = chain & 7, u = chain * NCK + c;
        const float* GA = (const float*)(p.ws + WS_GA) + (size_t)chain * LT + c * TC;
        float a = tid < TC ? GA[tid] : -1e30f;
        float m = a;
#pragma unroll
        for (int o = 32; o >= 1; o >>= 1) m = fmaxf(m, __shfl_xor(m, o));
        __syncthreads();
        if (lane == 0) red[wv] = m;
        __syncthreads();
        float mloc = red[0];
#pragma unroll
        for (int i = 1; i < 8; ++i) mloc = fmaxf(mloc, red[i]);
        if (tid < TC) wg[tid] = __expf(a - mloc);
        f32x4 acc[2][8];
#pragma unroll
        for (int i = 0; i < 2; ++i)
#pragma unroll
            for (int j = 0; j < 8; ++j) acc[i][j] = (f32x4){0.f, 0.f, 0.f, 0.f};
        float nacc = 0.f;
        u32x4 vreg[4], kreg[2];
#define P5_FETCH(sb_) do { \
            _Pragma("unroll") for (int i = 0; i < 4; ++i) { const int item = tid + NT * i, s_ = item >> 5, v8 = item & 31; const int r = pos_row(dir, c * TC + (sb_) * 64 + s_); \
                vreg[i] = *(const u32x4*)(P1 + (size_t)r * NREST + C_V + head * 256 + v8 * 8); } \
            _Pragma("unroll") for (int i = 0; i < 2; ++i) { const int item = tid + NT * i, s_ = item >> 4, d8 = item & 15; const int r = pos_row(dir, c * TC + (sb_) * 64 + s_); \
                kreg[i] = *(const u32x4*)(QK + (size_t)r * D + 1024 + head * 128 + d8 * 8); } } while (0)
        P5_FETCH(0);
        for (int sb = 0; sb < 4; ++sb) {
            __syncthreads();
#pragma unroll
            for (int i = 0; i < 4; ++i) { const int item = tid + NT * i, s_ = item >> 5, v8 = item & 31; *(u32x4*)(Vt + s_ * 264 + v8 * 8) = vreg[i]; }
#pragma unroll
            for (int i = 0; i < 2; ++i) {
                const int item = tid + NT * i, s_ = item >> 4, d8 = item & 15;
                const u32x4 w = kreg[i];
                const float g = wg[sb * 64 + s_];
                u32x4 o; o.x = pk2(blo(w.x) * g, bhi(w.x) * g); o.y = pk2(blo(w.y) * g, bhi(w.y) * g); o.z = pk2(blo(w.z) * g, bhi(w.z) * g); o.w = pk2(blo(w.w) * g, bhi(w.w) * g);
                *(u32x4*)(Kt + s_ * 136 + d8 * 8) = o;
            }
            __syncthreads();
            if (sb < 3) P5_FETCH(sb + 1);
            if (tid < 128) { float s2 = 0.f; for (int s_ = 0; s_ < 64; ++s_) s2 += bf2f(Kt[s_ * 136 + tid]); nacc += s2; }
#pragma unroll
            for (int kk = 0; kk < 2; ++kk) {
                bf16x8 af[2], bfr[8];
                const int trow = kk * 32 + fq * 8 + ((lane & 15) >> 2), tcol = (lane & 3) * 4;
#pragma unroll
                for (int mt = 0; mt < 2; ++mt) { const bf16_t* vb = Vt + trow * 264 + wv * 32 + mt * 16 + tcol;
                    const s16x4 lo = __builtin_amdgcn_ds_read_tr16_b64_v4i16((LAS s16x4*)(vb)), hi = __builtin_amdgcn_ds_read_tr16_b64_v4i16((LAS s16x4*)(vb + 4 * 264));
                    af[mt] = (bf16x8){lo[0], lo[1], lo[2], lo[3], hi[0], hi[1], hi[2], hi[3]}; }
#pragma unroll
                for (int nt = 0; nt < 8; ++nt) { const bf16_t* kb = Kt + trow * 136 + nt * 16 + tcol;
                    const s16x4 lo = __builtin_amdgcn_ds_read_tr16_b64_v4i16((LAS s16x4*)(kb)), hi = __builtin_amdgcn_ds_read_tr16_b64_v4i16((LAS s16x4*)(kb + 4 * 136));
                    bfr[nt] = (bf16x8){lo[0], lo[1], lo[2], lo[3], hi[0], hi[1], hi[2], hi[3]}; }
#pragma unroll
                for (int mt = 0; mt < 2; ++mt)
#pragma unroll
                    for (int nt = 0; nt < 8; ++nt) acc[mt][nt] = mfma16(af[mt], bfr[nt], acc[mt][nt]);
            }
        }
        float* SL = (float*)(p.ws + WS_SLOC) + (size_t)u * 256 * 128;
#pragma unroll
        for (int mt = 0; mt < 2; ++mt)
#pragma unroll
            for (int nt = 0; nt < 8; ++nt)
#pragma unroll
                for (int j = 0; j < 4; ++j) SL[(size_t)(wv * 32 + mt * 16 + fq * 4 + j) * 128 + nt * 16 + fr] = acc[mt][nt][j];
        if (tid < 128) ((float*)(p.ws + WS_NLOC))[(size_t)u * 128 + tid] = nacc;
        if (tid == 0) ((float*)(p.ws + WS_MLOC))[u] = mloc;
    }
    __syncthreads();
}

__device__ __forceinline__ void p6_scan(const Params& p) {
    const int tid = otid();
    const float* MLOC = (const float*)(p.ws + WS_MLOC);
    constexpr int EPC = 256 * 128 + 128;
    for (int item = blockIdx.x * NT + tid; item < NCH * EPC; item += gridDim.x * NT) {
        const int chain = item / EPC, e = item % EPC;
        float S = 0.f, mrun = -1e30f;
        const bool isS = e < 256 * 128;
#pragma unroll 1
        for (int c0 = 0; c0 < NCK; c0 += 11) {
            float loc[11];
#pragma unroll
            for (int i = 0; i < 11; ++i) { const int u = chain * NCK + c0 + i;
                loc[i] = isS ? ((const float*)(p.ws + WS_SLOC))[(size_t)u * 256 * 128 + e] : ((const float*)(p.ws + WS_NLOC))[(size_t)u * 128 + (e - 256 * 128)]; }
#pragma unroll
            for (int i = 0; i < 11; ++i) {
                const int u = chain * NCK + c0 + i;
                if (isS) ((bf16_t*)(p.ws + WS_SPRE))[(size_t)u * 256 * 128 + e] = f2bf(S);
                else ((float*)(p.ws + WS_NPRE))[(size_t)u * 128 + (e - 256 * 128)] = S;
                if (e == 0) ((float*)(p.ws + WS_MPRE))[u] = mrun;
                if (c0 + i < NCK - 1) {
                    const float ml = MLOC[u];
                    const float mnew = fmaxf(mrun, ml);
                    S = S * __expf(mrun - mnew) + loc[i] * __expf(ml - mnew);
                    mrun = mnew;
                }
            }
        }
    }
}

__device__ __forceinline__ void p7_mlstm_out(const Params& p, unsigned char* lds) {
    const int tid = otid(), lane = tid & 63, wv = tid >> 6, fr = lane & 15, fq = lane >> 4;
    const bf16_t* P1 = (const bf16_t*)(p.ws + WS_P1);
    const bf16_t* QK = (const bf16_t*)(p.ws + WS_QK);
    bf16_t* Qs = (bf16_t*)lds;
    float* rowM = (float*)(lds + 64 * 136 * 2);
    float* rowB = rowM + 64;
    float* denS = rowB + 64;
    float* asS = denS + 64;
    float* npS = asS + 64;
    float* ssq = npS + 128;
    unsigned char* big = lds + 64 * 136 * 2 + 2048;
    bf16_t* Ss = (bf16_t*)big;
    bf16_t* Ks = (bf16_t*)big;
    bf16_t* Vt = (bf16_t*)(big + 64 * 136 * 2);
    bf16_t* Ps = (bf16_t*)(big + 64 * 136 * 2 + 256 * 72 * 2);
    const int rt = wv & 3, ch = wv >> 2;
    for (int u = blockIdx.x; u < 8 * 128; u += gridDim.x) {
        const int head = u >> 7, tb = u & 127;
        f32x4 hs[8];
#pragma unroll
        for (int j = 0; j < 8; ++j) hs[j] = (f32x4){0.f, 0.f, 0.f, 0.f};
        __syncthreads();
        {
#pragma unroll
            for (int i = 0; i < 2; ++i) { const int item = tid + NT * i, r = item >> 4, c8 = item & 15;
                *(u32x4*)(Qs + r * 136 + c8 * 8) = *(const u32x4*)(QK + (size_t)(tb * 64 + r) * D + head * 128 + c8 * 8); }
        }
        for (int dir = 0; dir < 2; ++dir) {
            const int chain = dir * 8 + head, pb = dir ? 131 - tb : 4 + tb, c = pb >> 2;
            const int uu = chain * NCK + c;
            const float* GA = (const float*)(p.ws + WS_GA) + (size_t)chain * LT; const float* GB = (const float*)(p.ws + WS_GB) + (size_t)chain * LT; const float* GM = (const float*)(p.ws + WS_GM) + (size_t)chain * LT;
            const float mprev = ((const float*)(p.ws + WS_MPRE))[uu];
            __syncthreads();
            if (tid < 64) { const int pos = dir ? pb * 64 + 63 - tid : pb * 64 + tid; rowM[tid] = GM[pos]; rowB[tid] = GB[pos]; }
            if (tid >= 64 && tid < 192) npS[tid - 64] = ((const float*)(p.ws + WS_NPRE))[(size_t)uu * 128 + tid - 64];
            {
                const bf16_t* SP = (const bf16_t*)(p.ws + WS_SPRE) + (size_t)uu * 256 * 128;
#pragma unroll
                for (int i = 0; i < 8; ++i) { const int item = tid + NT * i, r = item >> 4, c8 = item & 15;
                    *(u32x4*)(Ss + r * 136 + c8 * 8) = *(const u32x4*)(SP + (size_t)r * 128 + c8 * 8); }
            }
            __syncthreads();
            u32x4 kreg[2], vreg[4]; float areg = 0.f;
#define P7_FETCH(pb2_) do { const int tb2_ = dir ? 131 - (pb2_) : (pb2_) - 4; \
                _Pragma("unroll") for (int i = 0; i < 2; ++i) { const int item = tid + NT * i, r = item >> 4, c8 = item & 15; kreg[i] = *(const u32x4*)(QK + (size_t)(tb2_ * 64 + r) * D + 1024 + head * 128 + c8 * 8); } \
                _Pragma("unroll") for (int i = 0; i < 4; ++i) { const int item = tid + NT * i, s_ = item >> 5, v8 = item & 31; vreg[i] = *(const u32x4*)(P1 + (size_t)(tb2_ * 64 + s_) * NREST + C_V + head * 256 + v8 * 8); } \
                if (tid < 64) { const int pos = dir ? (pb2_) * 64 + 63 - tid : (pb2_) * 64 + tid; areg = GA[pos]; } } while (0)
            P7_FETCH(c * 4);
            f32x4 acc[8];
#pragma unroll
            for (int j = 0; j < 8; ++j) acc[j] = (f32x4){0.f, 0.f, 0.f, 0.f};
#pragma unroll
            for (int kk = 0; kk < 4; ++kk) {
                const bf16x8 af = *(const bf16x8*)(Qs + (rt * 16 + fr) * 136 + kk * 32 + fq * 8);
#pragma unroll
                for (int j = 0; j < 8; ++j) { const bf16x8 bfr = *(const bf16x8*)(Ss + (ch * 128 + j * 16 + fr) * 136 + kk * 32 + fq * 8); acc[j] = mfma16(af, bfr, acc[j]); }
            }
            {
                float sc[4];
#pragma unroll
                for (int j2 = 0; j2 < 4; ++j2) sc[j2] = __expf(mprev - rowM[rt * 16 + fq * 4 + j2]);
#pragma unroll
                for (int j = 0; j < 8; ++j)
#pragma unroll
                    for (int j2 = 0; j2 < 4; ++j2) acc[j][j2] *= sc[j2];
            }
            float den = 0.f;
            if (tid < 64) { float s = 0.f; for (int d = 0; d < 128; ++d) s += bf2f(Qs[tid * 136 + d]) * npS[d]; den = s * __expf(mprev - rowM[tid]); }
            for (int pb2 = c * 4; pb2 <= pb; ++pb2) {
                __syncthreads();
                {
#pragma unroll
                    for (int i = 0; i < 2; ++i) { const int item = tid + NT * i, r = item >> 4, c8 = item & 15; *(u32x4*)(Ks + r * 136 + c8 * 8) = kreg[i]; }
#pragma unroll
                    for (int i = 0; i < 4; ++i) { const int item = tid + NT * i, s2 = item >> 5, v8 = item & 31; *(u32x4*)(Vt + s2 * 264 + v8 * 8) = vreg[i]; }
                    if (tid < 64) asS[tid] = areg;
                }
                __syncthreads();
                if (pb2 < pb) P7_FETCH(pb2 + 1);
                {
#pragma unroll
                    for (int t2 = 0; t2 < 2; ++t2) {
                        const int st = ch * 2 + t2;
                        f32x4 pa = {0.f, 0.f, 0.f, 0.f};
#pragma unroll
                        for (int kk = 0; kk < 4; ++kk) {
                            const bf16x8 af = *(const bf16x8*)(Qs + (rt * 16 + fr) * 136 + kk * 32 + fq * 8);
                            const bf16x8 bfr = *(const bf16x8*)(Ks + (st * 16 + fr) * 136 + kk * 32 + fq * 8);
                            pa = mfma16(af, bfr, pa);
                        }
                        const int is = st * 16 + fr; const float as = asS[is];
#pragma unroll
                        for (int j2 = 0; j2 < 4; ++j2) {
                            const int it = rt * 16 + fq * 4 + j2;
                            bool ok = true;
                            if (pb2 == pb) ok = dir ? (is >= it) : (is <= it);
                            const float w = ok ? __expf(as - rowM[it]) : 0.f;
                            Ps[it * 72 + is] = f2bf(pa[j2] * w);
                        }
                    }
                }
                __syncthreads();
                if (tid < 64) { float s = 0.f; for (int i = 0; i < 64; ++i) s += bf2f(Ps[tid * 72 + i]); den += s; }
#pragma unroll
                for (int kk = 0; kk < 2; ++kk) {
                    const bf16x8 af = *(const bf16x8*)(Ps + (rt * 16 + fr) * 72 + kk * 32 + fq * 8);
#pragma unroll
                    for (int j = 0; j < 8; ++j) {
                        const bf16_t* vb = Vt + (kk * 32 + fq * 8 + ((lane & 15) >> 2)) * 264 + ch * 128 + j * 16 + (lane & 3) * 4;
                        const s16x4 lo = __builtin_amdgcn_ds_read_tr16_b64_v4i16((LAS s16x4*)(vb)), hi = __builtin_amdgcn_ds_read_tr16_b64_v4i16((LAS s16x4*)(vb + 4 * 264));
                        const bf16x8 bfr = {lo[0], lo[1], lo[2], lo[3], hi[0], hi[1], hi[2], hi[3]};
                        acc[j] = mfma16(af, bfr, acc[j]); }
                }
            }
            if (tid < 64) { const float mt = rowB[tid] + rowM[tid]; denS[tid] = 1.0f / fmaxf(fabsf(den), __expf(-mt)); }
            __syncthreads();
            {
                float dn[4];
#pragma unroll
                for (int j2 = 0; j2 < 4; ++j2) dn[j2] = denS[rt * 16 + fq * 4 + j2];
#pragma unroll
                for (int j = 0; j < 8; ++j)
#pragma unroll
                    for (int j2 = 0; j2 < 4; ++j2) hs[j][j2] += acc[j][j2] * dn[j2];
            }
        }
        {
            float s4[4] = {0.f, 0.f, 0.f, 0.f};
#pragma unroll
            for (int j = 0; j < 8; ++j)
#pragma unroll
                for (int j2 = 0; j2 < 4; ++j2) s4[j2] += hs[j][j2] * hs[j][j2];
#pragma unroll
            for (int j2 = 0; j2 < 4; ++j2) {
#pragma unroll
                for (int o = 1; o <= 8; o <<= 1) s4[j2] += __shfl_xor(s4[j2], o);
            }
            __syncthreads();
            if (fr == 0) {
#pragma unroll
                for (int j2 = 0; j2 < 4; ++j2) ssq[ch * 64 + rt * 16 + fq * 4 + j2] = s4[j2];
            }
            __syncthreads();
            bf16_t* HML = (bf16_t*)(p.ws + WS_HML);
            float* Hs = (float*)big;
#pragma unroll
            for (int j2 = 0; j2 < 4; ++j2) {
                const int it = rt * 16 + fq * 4 + j2;
                const float rinv = rsqrtf((ssq[it] + ssq[64 + it]) * (1.0f / 256.0f) + EPS);
#pragma unroll
                for (int j = 0; j < 8; ++j) Hs[it * 260 + ch * 128 + j * 16 + fr] = hs[j][j2] * rinv;
            }
            __syncthreads();
#pragma unroll
            for (int i = 0; i < 4; ++i) {
                const int item = tid + NT * i, it = item >> 5, c8 = (item & 31) * 8;
                const int trow = tb * 64 + it, col = head * 256 + c8;
                const u32x4 ow = *(const u32x4*)(P1 + (size_t)trow * NREST + C_O + col);
                const f32x4 g0 = *(const f32x4*)(p.ml_norm_g + col), g1 = *(const f32x4*)(p.ml_norm_g + col + 4);
                const f32x4 h0 = *(const f32x4*)(Hs + it * 260 + c8), h1 = *(const f32x4*)(Hs + it * 260 + c8 + 4);
                u32x4 w;
                w.x = pk2(h0[0] * g0[0] * sigmoidf_(blo(ow.x)), h0[1] * g0[1] * sigmoidf_(bhi(ow.x))); w.y = pk2(h0[2] * g0[2] * sigmoidf_(blo(ow.y)), h0[3] * g0[3] * sigmoidf_(bhi(ow.y)));
                w.z = pk2(h1[0] * g1[0] * sigmoidf_(blo(ow.z)), h1[1] * g1[1] * sigmoidf_(bhi(ow.z))); w.w = pk2(h1[2] * g1[2] * sigmoidf_(blo(ow.w)), h1[3] * g1[3] * sigmoidf_(bhi(ow.w)));
                *(u32x4*)(HML + (size_t)trow * D + col) = w;
            }
        }
    }
    __syncthreads();
}

struct cf { float x, y; };
__device__ __forceinline__ cf cmul(cf a, cf b) { return cf{a.x * b.x - a.y * b.y, a.x * b.y + a.y * b.x}; }
__device__ __forceinline__ cf cmulc(cf a, cf b) { return cf{a.x * b.x + a.y * b.y, a.y * b.x - a.x * b.y}; }
constexpr int FM = 8192;
__device__ __forceinline__ int fphys(int i) { return i + (i >> 3); }
constexpr int FARR = (FM + FM / 8) * 8;
__device__ constexpr float c16(int n) { return n==0?1.f: n==1?0.92387953251f: n==2?0.70710678119f: n==3?0.38268343237f: n==4?0.f: n==5?-0.38268343237f: n==6?-0.70710678119f: -0.92387953251f; }
__device__ constexpr float s16(int n) { return n==0?0.f: n==1?0.38268343237f: n==2?0.70710678119f: n==3?0.92387953251f: n==4?1.f: n==5?0.92387953251f: n==6?0.70710678119f: 0.38268343237f; }
typedef float c2 __attribute__((ext_vector_type(2)));
__device__ __forceinline__ c2 bx(c2 a) { return (c2){a.x, a.x}; }
__device__ __forceinline__ c2 by(c2 a) { return (c2){a.y, a.y}; }
template <int A, bool INV>
__device__ __forceinline__ void fft_pass(cf* Xc, int s, int tid) {
    c2* X = (c2*)Xc;
    constexpr int R = 1 << A;
    const int hl = FM >> (s + A);
    for (int sub = tid; sub < FM / R; sub += NT) {
        const int lo = sub & (hl - 1), hi = sub / hl;
        const int base = hi * (hl * R) + lo;
        c2 v[R];
        const int pbase = fphys(base);
#define FOFF(m_) (hl >= 8 ? (m_) * (hl + (hl >> 3)) : ((m_) * hl + (((m_) * hl) >> 3)))
#pragma unroll
        for (int m = 0; m < R; ++m) v[m] = X[pbase + FOFF(m)];
        float sn, cs;
        int lo_ = lo; asm volatile("" : "+v"(lo_));
        __sincosf(-6.283185307179586f * (float)lo_ / (float)(hl * R), &sn, &cs);
        c2 w[A];
        w[0] = (c2){cs, sn};
#pragma unroll
        for (int t = 1; t < A; ++t) { const c2 q = w[t - 1]; w[t] = bx(q) * q + by(q) * (c2){-q.y, q.x}; }
#pragma unroll
        for (int tt = 0; tt < A; ++tt) {
            const int t = INV ? A - 1 - tt : tt;
            const int hm = 1 << (A - 1 - t);
            c2 ta[R / 2], tb[R / 2];
#pragma unroll
            for (int jm = 0; jm < R / 2; ++jm) {
                if (jm >= hm) continue;
                const int n16 = (jm << t) * (16 / R);
                const float c = c16(n16), sg = s16(n16);
                const c2 q = w[t];
                const c2 tw = (c2){c * q.x + sg * q.y, c * q.y - sg * q.x};
                if (!INV) { ta[jm] = tw; tb[jm] = (c2){-tw.y, tw.x}; }
                else { ta[jm] = (c2){tw.x, -tw.y}; tb[jm] = (c2){tw.y, tw.x}; }
            }
#pragma unroll
            for (int m = 0; m < R; ++m) {
                if (m & hm) continue;
                const int jm = m & (hm - 1);
                const c2 a = v[m], b = v[m + hm];
                if (!INV) { const c2 d = a - b; v[m] = a + b; v[m + hm] = bx(d) * ta[jm] + by(d) * tb[jm]; }
                else { const c2 e = bx(b) * ta[jm] + by(b) * tb[jm]; v[m] = a + e; v[m + hm] = a - e; }
            }
        }
#pragma unroll
        for (int m = 0; m < R; ++m) X[pbase + FOFF(m)] = v[m];
#undef FOFF
    }
}
__device__ __forceinline__ int brev13(int k) { return (int)(__brev((unsigned)k) >> 19); }
__device__ __forceinline__ void spec_mul(cf* Z, const cf* G, int tid) {
    for (int idx = tid; idx <= FM / 2; idx += NT) {
        const int p = idx < FM / 2 ? 2 * idx : 1;
        const int k = brev13(p), k2 = (FM - k) & (FM - 1);
        const int pa = fphys(p), pb = fphys(brev13(k2));
        const cf a = Z[pa], b = Z[pb], c = G[pa], d = G[pb];
        const cf Ex{0.5f * (a.x + b.x), 0.5f * (a.y - b.y)};
        const cf tx{0.5f * (a.x - b.x), 0.5f * (a.y + b.y)};
        const cf Ox{tx.y, -tx.x};
        const cf Eg{0.5f * (c.x + d.x), 0.5f * (c.y - d.y)};
        const cf tg{0.5f * (c.x - d.x), 0.5f * (c.y + d.y)};
        const cf Og{tg.y, -tg.x};
        float sn, cs;
        __sincosf(-6.283185307179586f * (float)k / (float)FM, &sn, &cs);
        const cf oo = cmul(cmul(Ox, Og), cf{cs, sn});
        const cf ee = cmul(Ex, Eg);
        const cf Ey{ee.x + oo.x, ee.y + oo.y};
        const cf eo = cmul(Ex, Og), oe = cmul(Ox, Eg);
        const cf Oy{eo.x + oe.x, eo.y + oe.y};
        const float sc = 1.0f / (float)FM;
        Z[pa] = cf{(Ey.x - Oy.y) * sc, (Ey.y + Oy.x) * sc};
        if (pb != pa) Z[pb] = cf{(Ey.x + Oy.y) * sc, (-Ey.y + Oy.x) * sc};
    }
}
#define GFI(j) (2 * fphys((j) >> 1) + ((j) & 1))
__device__ __forceinline__ void hy_filter(const Params& p, int c, int o, float* Gf) {
    const int tid = otid();
    const bf16_t* FW = (const bf16_t*)(p.ws + WS_FILT) + (size_t)(o * 2048 + c) * 8192;
    const bf16_t* BW = (const bf16_t*)(p.ws + WS_FILT) + (size_t)(4096 + o * 2048 + c) * 8192;
    const float bias = p.hy_bias[o * 2048 + c];
#pragma unroll
    for (int i = 0; i < 2; ++i) {
        const int t8 = (tid + NT * i) * 8;
        const u32x4 f = *(const u32x4*)(FW + t8), b = *(const u32x4*)(BW + t8);
        const float fv[8] = {blo(f.x), bhi(f.x), blo(f.y), bhi(f.y), blo(f.z), bhi(f.z), blo(f.w), bhi(f.w)};
        const float bv[8] = {blo(b.x), bhi(b.x), blo(b.y), bhi(b.y), blo(b.z), bhi(b.z), blo(b.w), bhi(b.w)};
#pragma unroll
        for (int e = 0; e < 8; ++e) {
            const int t = t8 + e;
            if (t == 0) { Gf[GFI(0)] = fv[0] + bv[0] + bias; Gf[GFI(8192)] = 0.f; }
            else { Gf[GFI(t)] = fv[e]; Gf[GFI(16384 - t)] = bv[e]; }
        }
    }
}
__device__ __forceinline__ void hy_short8(const bf16_t* row, int t8, float w0, float w1, float w2, float* out) {
    const u32x4 w = *(const u32x4*)(row + t8);
    const float prev = t8 > 0 ? bf2f(row[t8 - 1]) : 0.f, next = t8 + 8 < L ? bf2f(row[t8 + 8]) : 0.f;
    const float r[10] = {prev, blo(w.x), bhi(w.x), blo(w.y), bhi(w.y), blo(w.z), bhi(w.z), blo(w.w), bhi(w.w), next};
#pragma unroll
    for (int e = 0; e < 8; ++e) out[e] = r[e] * w0 + r[e + 1] * w1 + r[e + 2] * w2;
}
__device__ __forceinline__ void hy_tw4(int n0, c2* w) {
    float sn, cs; __sincosf(-6.283185307179586f * (float)n0 / (float)FM, &sn, &cs);
    w[0] = (c2){cs, sn};
    const c2 w1 = {0.99999970586f, -7.6699031874e-4f};
#pragma unroll
    for (int j = 1; j < 4; ++j) { const c2 q = w[j - 1]; w[j] = (c2){q.x * w1.x - q.y * w1.y, q.x * w1.y + q.y * w1.x}; }
}
__device__ __forceinline__ void p8_hyena(const Params& p, unsigned char* lds) {
    const int tid = otid();
    cf* Z = (cf*)lds; cf* G = (cf*)(lds + FARR);
    c2* Z2 = (c2*)lds;
    const bf16_t* HYT = (const bf16_t*)(p.ws + WS_HYT);
    bf16_t* HYOT = (bf16_t*)(p.ws + WS_HYOT);
    for (int c = blockIdx.x; c < 2048; c += gridDim.x) {
        const bf16_t* rx1 = HYT + (size_t)c * L; const bf16_t* rx2 = HYT + (size_t)(2048 + c) * L; const bf16_t* rv = HYT + (size_t)(4096 + c) * L;
        const float* cw = p.hy_conv_w;
        const float a0 = cw[c], a1 = cw[6144 + c], a2 = cw[2 * 6144 + c];
        const float b0 = cw[2048 + c], b1 = cw[6144 + 2048 + c], b2 = cw[2 * 6144 + 2048 + c];
        const float v0 = cw[4096 + c], v1 = cw[6144 + 4096 + c], v2 = cw[2 * 6144 + 4096 + c];
        __syncthreads();
#pragma unroll
        for (int i = 0; i < 2; ++i) {
            const int t8 = (tid + NT * i) * 8, n0 = t8 >> 1;
            float z[8]; hy_short8(rv, t8, v0, v1, v2, z);
            c2 w[4]; hy_tw4(n0, w);
#pragma unroll
            for (int j = 0; j < 4; ++j) { const c2 a = {z[2 * j], z[2 * j + 1]}; Z2[fphys(n0 + j)] = a; Z2[fphys(n0 + j + FM / 2)] = (c2){a.x * w[j].x - a.y * w[j].y, a.x * w[j].y + a.y * w[j].x}; }
        }
        for (int o = 0; o < 2; ++o) {
            hy_filter(p, c, o, (float*)G);
            __syncthreads();
            fft_pass<4, false>(Z, 1, tid); asm volatile("" ::: "memory"); __builtin_amdgcn_sched_barrier(0); fft_pass<4, false>(G, 0, tid); __syncthreads();
            fft_pass<4, false>(Z, 5, tid); asm volatile("" ::: "memory"); __builtin_amdgcn_sched_barrier(0); fft_pass<3, false>(G, 4, tid); __syncthreads();
            fft_pass<4, false>(Z, 9, tid); asm volatile("" ::: "memory"); __builtin_amdgcn_sched_barrier(0); fft_pass<3, false>(G, 7, tid); __syncthreads();
            fft_pass<3, false>(G, 10, tid); __syncthreads();
            spec_mul(Z, G, tid); __syncthreads();
            fft_pass<4, true>(Z, 9, tid); __syncthreads();
            fft_pass<4, true>(Z, 5, tid); __syncthreads();
            fft_pass<4, true>(Z, 1, tid); __syncthreads();
#pragma unroll
            for (int i = 0; i < 2; ++i) {
                const int t8 = (tid + NT * i) * 8, n0 = t8 >> 1;
                float x[8];
                if (o == 0) hy_short8(rx1, t8, a0, a1, a2, x); else hy_short8(rx2, t8, b0, b1, b2, x);
                c2 w[4]; hy_tw4(n0, w);
                unsigned ww[4];
#pragma unroll
                for (int j = 0; j < 4; ++j) {
                    const c2 lo = Z2[fphys(n0 + j)], hi = Z2[fphys(n0 + j + FM / 2)];
                    const c2 y = {lo.x + hi.x * w[j].x + hi.y * w[j].y, lo.y + hi.y * w[j].x - hi.x * w[j].y};
                    const c2 r = {y.x * x[2 * j], y.y * x[2 * j + 1]};
                    if (o == 0) { Z2[fphys(n0 + j)] = r; Z2[fphys(n0 + j + FM / 2)] = (c2){r.x * w[j].x - r.y * w[j].y, r.x * w[j].y + r.y * w[j].x}; }
                    else ww[j] = pk2(r.x, r.y);
                }
                if (o == 1) { u32x4 wv4; wv4.x = ww[0]; wv4.y = ww[1]; wv4.z = ww[2]; wv4.w = ww[3]; *(u32x4*)(HYOT + (size_t)c * L + t8) = wv4; }
            }
        }
    }
    __syncthreads();
}

__device__ __forceinline__ void p9_transpose(const Params& p, unsigned char* lds) {
    const int tid = otid();
    bf16_t* T = (bf16_t*)lds;
    const bf16_t* S = (const bf16_t*)(p.ws + WS_HYOT); bf16_t* O = (bf16_t*)(p.ws + WS_HYO);
    for (int tix = blockIdx.x; tix < 32 * 128; tix += gridDim.x) {
        const int ct = tix >> 7, tt = tix & 127;
        __syncthreads();
        { const int r = tid >> 3, c8 = tid & 7; const u32x4 w = *(const u32x4*)(S + (size_t)(ct * 64 + r) * L + tt * 64 + c8 * 8);
          unsigned* d = (unsigned*)(T + r * 66 + c8 * 8); d[0] = w.x; d[1] = w.y; d[2] = w.z; d[3] = w.w; }
        __syncthreads();
        { const int t = tid >> 3, c8 = tid & 7; u32x4 w;
          w.x = (unsigned)T[(c8 * 8 + 0) * 66 + t] | ((unsigned)T[(c8 * 8 + 1) * 66 + t] << 16); w.y = (unsigned)T[(c8 * 8 + 2) * 66 + t] | ((unsigned)T[(c8 * 8 + 3) * 66 + t] << 16);
          w.z = (unsigned)T[(c8 * 8 + 4) * 66 + t] | ((unsigned)T[(c8 * 8 + 5) * 66 + t] << 16); w.w = (unsigned)T[(c8 * 8 + 6) * 66 + t] | ((unsigned)T[(c8 * 8 + 7) * 66 + t] << 16);
          *(u32x4*)(O + (size_t)(tt * 64 + t) * D + ct * 64 + c8 * 8) = w; }
    }
    __syncthreads();
}
__device__ __forceinline__ void p12_tables(const Params& p) {
    const int tid = otid(), lane = tid & 63, wv = tid >> 6;
    for (int row = blockIdx.x * 8 + wv; row < 2 * 16384; row += gridDim.x * 8) {
        const bool second = row >= 16384; const int r = second ? row - 16384 : row;
        const float* src = (second ? p.peer_v : p.peer_u) + (size_t)r * D;
        f32x4 v[2][4]; float am = 0.f;
#pragma unroll
        for (int i = 0; i < 2; ++i)
#pragma unroll
            for (int j = 0; j < 4; ++j) { v[i][j] = *(const f32x4*)(src + 16 * (lane + 64 * i) + 4 * j);
                am = fmaxf(am, fmaxf(fmaxf(fabsf(v[i][j][0]), fabsf(v[i][j][1])), fmaxf(fabsf(v[i][j][2]), fabsf(v[i][j][3])))); }
#pragma unroll
        for (int o = 32; o >= 1; o >>= 1) am = fmaxf(am, __shfl_xor(am, o));
        const float inv = am > 0.f ? 440.0f / am : 0.f;
        unsigned char* dst = p.ws + (second ? WS_PV : WS_PU) + (size_t)r * D;
#pragma unroll
        for (int i = 0; i < 2; ++i) {
            u32x4 w;
#pragma unroll
            for (int j = 0; j < 4; ++j) { int x = 0;
                x = __builtin_amdgcn_cvt_pk_fp8_f32(v[i][j][0] * inv, v[i][j][1] * inv, x, false);
                x = __builtin_amdgcn_cvt_pk_fp8_f32(v[i][j][2] * inv, v[i][j][3] * inv, x, true);
                w[j] = (unsigned)x; }
            *(u32x4*)(dst + 16 * (lane + 64 * i)) = w;
        }
        if (lane == 0) ((float*)(p.ws + (second ? WS_PSV : WS_PSU)))[r] = am > 0.f ? am / 440.0f : 0.f;
    }
    for (int i = blockIdx.x * NT + tid; i < 8 * 2 * 128 * 128 / 2; i += gridDim.x * NT) ((unsigned*)(p.ws + WS_KEYB))[i] = pk2(p.peer_keys[2 * i], p.peer_keys[2 * i + 1]);
}
typedef float f32x2 __attribute__((ext_vector_type(2)));
#define CVT2(w_, hi_) __builtin_amdgcn_cvt_pk_f32_fp8((int)(w_), (hi_))
__device__ __forceinline__ f32x2 dot16_fp8(u32x4 w8, const f32x2* tv, f32x2 s) {
    s += CVT2(w8.x, false) * tv[0]; s += CVT2(w8.x, true) * tv[1]; s += CVT2(w8.y, false) * tv[2]; s += CVT2(w8.y, true) * tv[3];
    s += CVT2(w8.z, false) * tv[4]; s += CVT2(w8.z, true) * tv[5]; s += CVT2(w8.w, false) * tv[6]; s += CVT2(w8.w, true) * tv[7];
    return s;
}
__device__ __forceinline__ void axpy16_fp8(u32x4 w8, f32x2 act2, f32x2* ao) {
    ao[0] += act2 * CVT2(w8.x, false); ao[1] += act2 * CVT2(w8.x, true); ao[2] += act2 * CVT2(w8.y, false); ao[3] += act2 * CVT2(w8.y, true);
    ao[4] += act2 * CVT2(w8.z, false); ao[5] += act2 * CVT2(w8.z, true); ao[6] += act2 * CVT2(w8.w, false); ao[7] += act2 * CVT2(w8.w, true);
}
__device__ __forceinline__ f32x2 gelu_pk(f32x2 v) {
    const f32x2 av = __builtin_elementwise_abs(v), d = av * 0.2316418882f + 1.0f;
    f32x2 t; t.x = __builtin_amdgcn_rcpf(d.x); t.y = __builtin_amdgcn_rcpf(d.y);
    f32x2 q = t * 0.5307027145f + (-0.7265760135f); q = q * t + 0.7107068705f; q = q * t + (-0.142248368f); q = q * t + 0.127414796f; q = q * t;
    const f32x2 s = (v * v) * (-0.72134752044f);
    f32x2 e; e.x = __builtin_amdgcn_exp2f(s.x); e.y = __builtin_amdgcn_exp2f(s.y);
    const f32x2 m = v * (q * e), r = v - m;
    f32x2 o; o.x = v.x < 0.f ? m.x : r.x; o.y = v.y < 0.f ? m.y : r.y; return o;
}
struct ExGroup { u32x4 uw[GX][2], vw[GX][2]; float gg[GX], su[GX], sv[GX]; };

__device__ __forceinline__ void wave_argmax(float& bv, int& bi) {
#pragma unroll
    for (int o = 32; o >= 1; o >>= 1) {
        const float ov = __shfl_xor(bv, o); const int oi = __shfl_xor(bi, o);
        if (ov > bv || (ov == bv && oi < bi)) { bv = ov; bi = oi; }
    }
}
__device__ __forceinline__ void top16_128(float v0, float v1, int lane, float& outS, int& outI) {
    outS = 0.f; outI = 0;
#pragma unroll 1
    for (int it = 0; it < 16; ++it) {
        const bool u1 = v1 > v0; float bv = u1 ? v1 : v0; int bi = u1 ? lane + 64 : lane;
        wave_argmax(bv, bi);
        if (lane == it) { outS = bv; outI = bi; }
        if (bi == lane) v0 = -3.0e38f; else if (bi == lane + 64) v1 = -3.0e38f;
    }
}
__device__ __forceinline__ void p14_peer(const Params& p, unsigned char* lds) {
    const int tid = otid(), lane = tid & 63, wv = tid >> 6, fr = lane & 15, fq = lane >> 4;
    const bf16_t* QP = (const bf16_t*)(p.ws + WS_QP);
    const bf16_t* VL = (const bf16_t*)(p.ws + WS_VL);
    const float* HLAT = (const float*)(p.ws + WS_HLAT);
    const float* MOD = (const float*)(p.ws + WS_MOD);
    float* Sc = (float*)lds;
    int* eS = (int*)(lds + 2 * 32 * 2 * 132 * 4);
    float* gS = (float*)(eS + 32 * 128);
    float* tS = gS + 32 * 128;
    int* tI = (int*)(tS + 32 * 2 * 16);
    float* cSw = (float*)(tI + 32 * 2 * 16);
    float* lSw = cSw + 8 * 64;
    const bf16_t* KEYB = (const bf16_t*)(p.ws + WS_KEYB);
    int ca = 0, cb = 0;
    { int rem = lane; for (ca = 0; ca < 16; ++ca) { const int cnt = 16 / (ca + 1); if (rem < cnt) break; rem -= cnt; } cb = rem; if (lane >= 50) { ca = 0; cb = 0; } }
    for (int u = blockIdx.x; u < L / 32; u += gridDim.x) {
        const int t0 = u * 32;
        const int rt = wv & 1;
        int fq8o = fq * 8; asm volatile("" : "+v"(fq8o));
        bf16x8 af[2][4];
#define SC_LOAD(hh_) do { _Pragma("unroll") for (int pp = 0; pp < 2; ++pp) _Pragma("unroll") for (int kk = 0; kk < 4; ++kk) \
            af[pp][kk] = *(const bf16x8*)(QP + (size_t)(t0 + rt * 16 + fr) * D + (hh_) * 256 + pp * 128 + kk * 32 + fq8o); } while (0)
        SC_LOAD(0);
#pragma unroll 1
        for (int h = 0; h < 8; ++h) {
            float* ScH = Sc + (h & 1) * (32 * 2 * 132);
            {
                bf16x8 bfr[2][2][4];
#pragma unroll
                for (int pp = 0; pp < 2; ++pp)
#pragma unroll
                    for (int kk = 0; kk < 4; ++kk)
#pragma unroll
                        for (int t2 = 0; t2 < 2; ++t2) bfr[pp][t2][kk] = *(const bf16x8*)(KEYB + ((size_t)(h * 2 + pp) * 128 + ((wv >> 1) * 2 + t2) * 16 + fr) * 128 + kk * 32 + fq8o);
#pragma unroll
                for (int pp = 0; pp < 2; ++pp)
#pragma unroll
                    for (int t2 = 0; t2 < 2; ++t2) {
                        const int kt = (wv >> 1) * 2 + t2;
                        f32x4 acc = {0.f, 0.f, 0.f, 0.f};
#pragma unroll
                        for (int kk = 0; kk < 4; ++kk) acc = mfma16(af[pp][kk], bfr[pp][t2][kk], acc);
#pragma unroll
                        for (int j = 0; j < 4; ++j) ScH[((rt * 16 + fq * 4 + j) * 2 + pp) * 132 + kt * 16 + fr] = __uint_as_float((__float_as_uint(acc[j]) & ~127u) | (unsigned)(127 - (kt * 16 + fr)));
                    }
                if (h + 1 < 8) SC_LOAD(h + 1);
            }
            __syncthreads();
            {
                unsigned k0[8], k1[8], T[8];
#pragma unroll
                for (int q = 0; q < 8; ++q) {
                    const float* row = ScH + ((wv * 4 + (q >> 1)) * 2 + (q & 1)) * 132;
                    const unsigned b0 = __float_as_uint(row[lane]), b1 = __float_as_uint(row[lane + 64]);
                    k0[q] = b0 ^ ((b0 >> 31) ? 0xFFFFFFFFu : 0x80000000u); k1[q] = b1 ^ ((b1 >> 31) ? 0xFFFFFFFFu : 0x80000000u);
                    T[q] = 0u;
                }
#pragma unroll 1
                for (int bit = 31; bit >= 7; --bit) {
#pragma unroll
                    for (int q = 0; q < 8; ++q) {
                        const unsigned cand = T[q] | (1u << bit);
                        const int cnt = __popcll(__ballot(k0[q] >= cand)) + __popcll(__ballot(k1[q] >= cand));
                        T[q] = cnt >= 16 ? cand : T[q];
                    }
                }
#pragma unroll
                for (int q = 0; q < 8; ++q) {
                    const int tk = wv * 4 + (q >> 1), pp = q & 1;
                    const float* row = ScH + (tk * 2 + pp) * 132;
                    const bool s0 = k0[q] >= T[q], s1 = k1[q] >= T[q];
                    const unsigned long long m0 = __ballot(s0), m1 = __ballot(s1);
                    const int p0 = __builtin_amdgcn_mbcnt_hi((unsigned)(m0 >> 32), __builtin_amdgcn_mbcnt_lo((unsigned)m0, 0u));
                    const int p1 = __popcll(m0) + __builtin_amdgcn_mbcnt_hi((unsigned)(m1 >> 32), __builtin_amdgcn_mbcnt_lo((unsigned)m1, 0u));
                    float* lS = lSw + (wv * 8 + q) * 32; int* lI = (int*)(lS + 16);
                    if (s0 && p0 < 16) { lS[p0] = row[lane]; lI[p0] = lane; }
                    if (s1 && p1 < 16) { lS[p1] = row[lane + 64]; lI[p1] = lane + 64; }
                }
                __builtin_amdgcn_wave_barrier();
#pragma unroll
                for (int rd = 0; rd < 2; ++rd) {
                    const int q = rd * 4 + (lane >> 4), j = lane & 15, tk = wv * 4 + (q >> 1), pp = q & 1;
                    const float* lS = lSw + (wv * 8 + q) * 32; const int* lI = (const int*)(lS + 16);
                    const float my = lS[j]; const int mi = lI[j];
                    int rk = 0;
#pragma unroll
                    for (int j4 = 0; j4 < 4; ++j4) { const f32x4 x = *(const f32x4*)(lS + j4 * 4);
#pragma unroll
                        for (int e = 0; e < 4; ++e) rk += (x[e] > my) ? 1 : 0; }
                    tS[(tk * 2 + pp) * 16 + rk] = my; tI[(tk * 2 + pp) * 16 + rk] = mi;
                }
            }
            __builtin_amdgcn_wave_barrier();
            {
                float cval[4]; unsigned ck[4], T[4];
#pragma unroll
                for (int q = 0; q < 4; ++q) {
                    const int tk = wv * 4 + q;
                    cval[q] = tS[(tk * 2) * 16 + ca] + tS[(tk * 2 + 1) * 16 + cb];
                    const unsigned bb = __float_as_uint(cval[q]);
                    ck[q] = lane < 50 ? (bb ^ ((bb >> 31) ? 0xFFFFFFFFu : 0x80000000u)) : 0u;
                    T[q] = 0u;
                }
#pragma unroll 1
                for (int bit = 31; bit >= 7; --bit) {
#pragma unroll
                    for (int q = 0; q < 4; ++q) {
                        const unsigned cand = T[q] | (1u << bit);
                        const int cnt = __popcll(__ballot(ck[q] >= cand));
                        T[q] = cnt >= 16 ? cand : T[q];
                    }
                }
                float ex[4]; int slot[4]; bool okw[4];
#pragma unroll
                for (int q = 0; q < 4; ++q) {
                    const int tk = wv * 4 + q;
                    const bool win = ck[q] >= T[q] && lane < 50;
                    const unsigned long long m = __ballot(win);
                    slot[q] = __builtin_amdgcn_mbcnt_hi((unsigned)(m >> 32), __builtin_amdgcn_mbcnt_lo((unsigned)m, 0u));
                    okw[q] = win && slot[q] < 16;
                    const float mx = tS[(tk * 2) * 16] + tS[(tk * 2 + 1) * 16];
                    ex[q] = okw[q] ? __expf(cval[q] - mx) : 0.f;
                }
                float sm[4];
#pragma unroll
                for (int q = 0; q < 4; ++q) sm[q] = ex[q];
#pragma unroll
                for (int o = 32; o >= 1; o >>= 1) {
#pragma unroll
                    for (int q = 0; q < 4; ++q) sm[q] += __shfl_xor(sm[q], o);
                }
#pragma unroll
                for (int q = 0; q < 4; ++q) {
                    const int tk = wv * 4 + q;
                    if (okw[q]) { eS[tk * 128 + h * 16 + slot[q]] = tI[(tk * 2) * 16 + ca] * 128 + tI[(tk * 2 + 1) * 16 + cb]; gS[tk * 128 + h * 16 + slot[q]] = ex[q] / sm[q]; }
                }
            }
        }
        __syncthreads();
        const unsigned char* PU8 = p.ws + WS_PU; const unsigned char* PV8 = p.ws + WS_PV;
        const float* PSU = (const float*)(p.ws + WS_PSU); const float* PSV = (const float*)(p.ws + WS_PSV);
#pragma unroll 1
#define GQ 4
        for (int q = 0; q < 4; ++q) {
            const int tk = wv * 4 + q, t = t0 + tk;
            f32x2 tv[16];
#pragma unroll
            for (int i = 0; i < 2; ++i)
#pragma unroll
                for (int hh = 0; hh < 2; ++hh) { const u32x4 w = *(const u32x4*)(VL + (size_t)t * D + 16 * (lane + 64 * i) + 8 * hh);
                    tv[i * 8 + hh * 4 + 0] = (f32x2){blo(w.x), bhi(w.x)}; tv[i * 8 + hh * 4 + 1] = (f32x2){blo(w.y), bhi(w.y)}; tv[i * 8 + hh * 4 + 2] = (f32x2){blo(w.z), bhi(w.z)}; tv[i * 8 + hh * 4 + 3] = (f32x2){blo(w.w), bhi(w.w)}; }
            struct UG { u32x4 uw[GQ][2]; float su[GQ], sv[GQ]; };
#define EXU_LOAD(G_, k0_) do { _Pragma("unroll") for (int x = 0; x < GQ; ++x) { const int e = eS[tk * 128 + (k0_) + x]; G_.su[x] = PSU[e]; G_.sv[x] = PSV[e]; \
        _Pragma("unroll") for (int i = 0; i < 2; ++i) G_.uw[x][i] = *(const u32x4*)(PU8 + (size_t)e * D + 16 * (lane + 64 * i)); } } while (0)
#define EXU_COMPUTE(G_, k0_) do { float d[GQ]; \
        _Pragma("unroll") for (int x = 0; x < GQ; ++x) { f32x2 s2 = {0.f, 0.f}; s2 = dot16_fp8(G_.uw[x][0], tv, s2); s2 = dot16_fp8(G_.uw[x][1], tv + 8, s2); d[x] = s2.x + s2.y; } \
        _Pragma("unroll") for (int o = 32; o >= 1; o >>= 1) { _Pragma("unroll") for (int x = 0; x < GQ; ++x) d[x] += __shfl_xor(d[x], o); } \
        const f32x2 g01 = gelu_pk((f32x2){d[0] * G_.su[0], d[1] * G_.su[1]}), g23 = gelu_pk((f32x2){d[2] * G_.su[2], d[3] * G_.su[3]}); \
        const float av = lane == 0 ? g01.x * G_.sv[0] : lane == 1 ? g01.y * G_.sv[1] : lane == 2 ? g23.x * G_.sv[2] : g23.y * G_.sv[3]; \
        if (lane < GQ) gS[tk * 128 + (k0_) + lane] *= av; } while (0)
            UG ga, gb;
            EXU_LOAD(ga, 0);
#pragma unroll 1
            for (int k0 = 0; k0 < 128; k0 += 2 * GQ) {
                EXU_LOAD(gb, k0 + GQ);
                EXU_COMPUTE(ga, k0);
                if (k0 + 2 * GQ < 128) EXU_LOAD(ga, k0 + 2 * GQ);
                EXU_COMPUTE(gb, k0 + GQ);
            }
        }
        __builtin_amdgcn_wave_barrier();
        for (int q = 0; q < 4; ++q) {
            const int tk = wv * 4 + q, t = t0 + tk;
            f32x2 ao[16];
#pragma unroll
            for (int i = 0; i < 16; ++i) ao[i] = (f32x2){0.f, 0.f};
            struct VG { u32x4 vw[GQ][2]; float act[GQ]; };
#define EXV_LOAD(G_, k0_) do { _Pragma("unroll") for (int x = 0; x < GQ; ++x) { const int e = eS[tk * 128 + (k0_) + x]; G_.act[x] = gS[tk * 128 + (k0_) + x]; \
        _Pragma("unroll") for (int i = 0; i < 2; ++i) G_.vw[x][i] = *(const u32x4*)(PV8 + (size_t)e * D + 16 * (lane + 64 * i)); } } while (0)
#define EXV_COMPUTE(G_) do { _Pragma("unroll") for (int x = 0; x < GQ; ++x) { const f32x2 act2 = {G_.act[x], G_.act[x]}; axpy16_fp8(G_.vw[x][0], act2, ao); axpy16_fp8(G_.vw[x][1], act2, ao + 8); } } while (0)
            VG ga, gb;
            EXV_LOAD(ga, 0);
#pragma unroll 1
            for (int k0 = 0; k0 < 128; k0 += 2 * GQ) {
                EXV_LOAD(gb, k0 + GQ);
                EXV_COMPUTE(ga);
                if (k0 + 2 * GQ < 128) EXV_LOAD(ga, k0 + 2 * GQ);
                EXV_COMPUTE(gb);
            }
            int lane16 = 16 * lane; asm volatile("" : "+v"(lane16));
            float ss = 0.f;
#pragma unroll
            for (int i = 0; i < 2; ++i)
#pragma unroll
                for (int j = 0; j < 4; ++j) {
                    const int c = lane16 + 1024 * i + 4 * j;
                    const f32x4 hv = *(const f32x4*)(HLAT + (size_t)t * D + c), g2 = *(const f32x4*)(MOD + 5 * D + c);
                    f32x2 v0 = ao[i * 8 + j * 2], v1 = ao[i * 8 + j * 2 + 1];
                    v0.x = hv[0] + g2[0] * v0.x; v0.y = hv[1] + g2[1] * v0.y; v1.x = hv[2] + g2[2] * v1.x; v1.y = hv[3] + g2[3] * v1.y;
                    ao[i * 8 + j * 2] = v0; ao[i * 8 + j * 2 + 1] = v1; ss += v0.x * v0.x + v0.y * v0.y + v1.x * v1.x + v1.y * v1.y;
                }
            ss = wave_sum(ss);
            const float rinv = rsqrtf(ss * (1.0f / D) + EPS);
#pragma unroll
            for (int i = 0; i < 2; ++i)
#pragma unroll
                for (int j = 0; j < 4; ++j) {
                    const int c = lane16 + 1024 * i + 4 * j;
                    const f32x4 fg = *(const f32x4*)(p.final_g + c);
                    const f32x2 v0 = ao[i * 8 + j * 2], v1 = ao[i * 8 + j * 2 + 1];
                    f32x4 o; o[0] = v0.x * rinv * fg[0]; o[1] = v0.y * rinv * fg[1]; o[2] = v1.x * rinv * fg[2]; o[3] = v1.y * rinv * fg[3];
                    *(f32x4*)(p.out + (size_t)t * D + c) = o;
                }
        }
    }
    __syncthreads();
}

__global__ void __launch_bounds__(NT, 2) fwd_megakernel(Params p) {
    extern __shared__ __attribute__((aligned(16))) unsigned char lds[];
    cg::grid_group grid = cg::this_grid();
    PG8_LAS unsigned char* ldsg = (PG8_LAS unsigned char*)lds;
    const int G = gridDim.x, bx = blockIdx.x;
    volatile LAS unsigned* xst = (volatile LAS unsigned*)((LAS unsigned char*)lds + LDS_MAIN);
    if (threadIdx.x < 4) xst[threadIdx.x] = 0u;
    __syncthreads();
    XcdBarrier bar = xcd_barrier_post((unsigned*)(p.ws + WS_BAR), xst);
#define W16(off) ((bf16_t*)(p.ws + (off)))
#define PHASE(k, body) do { body; if ((REPEAT_MASK >> (k)) & 1) { xcd_barrier(bar); body; } } while (0)
    PHASE(0, p0_gemv_hdn(p, lds));
    if (p.ph_lo < 0) grid.sync();
    xcd_barrier(bar);
    PHASE(1, ({ p1_filters(p); p1_weights(p, lds); }));
    xcd_barrier(bar);
    PHASE(2, p_rownorm<0>(p));
    xcd_barrier(bar);
    PHASE(3, ({ p3_side_tasks(p, lds);
                { pg8::Gemm g{W16(WS_WHY), W16(WS_U), 6144, L, D}; pg8::StaticOrder S; S.init(6144, L, G, bx); pg8::EpiBf16 E{W16(WS_HYT), L}; pg8::gemm_phase<pg8::EpiBf16, pg8::StaticOrder>(ldsg, g, S, E); }
                  { pg8::Gemm g{W16(WS_U), W16(WS_WREST), L, C_GT, D}; pg8::StaticOrder S; S.init(L, C_GT, G, bx); pg8::EpiBf16 E{W16(WS_P1), NREST}; pg8::gemm_phase<pg8::EpiBf16, pg8::StaticOrder>(ldsg, g, S, E); } }));
    xcd_barrier(bar);
    PHASE(8, p8_hyena(p, lds));
    PHASE(4, p4_conv_gates(p, lds));
    xcd_barrier(bar);
    PHASE(5, p5_local_states(p, lds));
    xcd_barrier(bar);
    PHASE(6, p6_scan(p));
    xcd_barrier(bar);
    PHASE(7, ({ if (bx & 1) p12_tables(p); p7_mlstm_out(p, lds); if (!(bx & 1)) p12_tables(p); }));
    PHASE(9, p9_transpose(p, lds));
    xcd_barrier(bar);
    PHASE(10, ({ { pg8::Gemm g{W16(WS_HML), W16(WS_WPM), L, D, D}; pg8::StaticOrder S; S.init(L, D, G, bx); pg8::EpiGate1 E{(float*)(p.ws + WS_Y1), D, W16(WS_P1) + C_BGM, NREST}; pg8::gemm_phase<pg8::EpiGate1, pg8::StaticOrder>(ldsg, g, S, E); }
                   { pg8::Gemm g{W16(WS_HYO), W16(WS_WPH), L, D, D}; pg8::StaticOrder S; S.init(L, D, G, bx); pg8::EpiGate2 E{(const float*)(p.ws + WS_Y1), W16(WS_Y), D, W16(WS_P1) + C_BGH, NREST}; pg8::gemm_phase<pg8::EpiGate2, pg8::StaticOrder>(ldsg, g, S, E); } }));
    xcd_barrier(bar);
    PHASE(11, ({ pg8::Gemm g{W16(WS_Y), W16(WS_WO), L, D, D}; pg8::StaticOrder S; S.init(L, D, G, bx); pg8::EpiRes E{p.x, (float*)(p.ws + WS_HLAT), D, (const float*)(p.ws + WS_MOD) + 2 * D}; pg8::gemm_phase<pg8::EpiRes, pg8::StaticOrder>(ldsg, g, S, E); }));
    xcd_barrier(bar);
    PHASE(12, p_rownorm<1>(p));
    xcd_barrier(bar);
    PHASE(13, ({ pg8::Gemm g{W16(WS_VL), W16(WS_WQ), L, D, D}; pg8::StaticOrder S; S.init(L, D, G, bx); pg8::EpiBf16 E{W16(WS_QP), D}; pg8::gemm_phase<pg8::EpiBf16, pg8::StaticOrder>(ldsg, g, S, E); }));
    xcd_barrier(bar);
    PHASE(14, p14_peer(p, lds));
}
constexpr int NPHASE = 15;

extern "C" void kernel_launch(void* const* d_in, const int* in_sizes, int n_in, void* d_out, int out_size, void* d_ws, size_t ws_size, hipStream_t stream) {
    static int grid = 0;
    if (grid == 0) {
        if (n_in != 28 || ws_size < WS_END) { fprintf(stderr, "kernel_launch: n_in %d ws_size %zu (need %zu)\n", n_in, ws_size, (size_t)WS_END); grid = -1; return; }
        int dev = 0, cus = 0, per_cu = 0;
        hipGetDevice(&dev);
        hipDeviceGetAttribute(&cus, hipDeviceAttributeMultiprocessorCount, dev);
        if (hipFuncSetAttribute((const void*)fwd_megakernel, hipFuncAttributeMaxDynamicSharedMemorySize, LDS_BYTES) != hipSuccess) { fprintf(stderr, "kernel_launch: hipFuncSetAttribute failed\n"); grid = -1; return; }
        if (hipOccupancyMaxActiveBlocksPerMultiprocessor(&per_cu, (const void*)fwd_megakernel, NT, LDS_BYTES) != hipSuccess || per_cu < 1) { fprintf(stderr, "kernel_launch: occupancy query says %d\n", per_cu); (void)hipGetLastError(); grid = -1; return; }
        grid = cus;
    }
    if (grid < 0) return;
    Params p{};
    const float** pf = (const float**)&p;
    for (int i = 0; i < 28; ++i) pf[i] = (const float*)d_in[i];
    p.out = (float*)d_out; p.ws = (unsigned char*)d_ws;
    p.ph_lo = 0; p.ph_hi = NPHASE;
    if (hipMemsetAsync((char*)d_ws + WS_BAR, 0, (size_t)XCD_BAR_WORDS * 4, stream) != hipSuccess) { fprintf(stderr, "kernel_launch: memset failed\n"); return; }
    void* args[] = {&p};
    hipError_t e = hipLaunchCooperativeKernel((void*)fwd_megakernel, dim3(grid), dim3(NT), args, LDS_BYTES, stream);
    if (e != hipSuccess) fprintf(stderr, "cooperative launch failed: %s (grid %d)\n", hipGetErrorString(e), grid);
}
```

```cpp
#include <hip/hip_runtime.h>
#include <hip/hip_cooperative_groups.h>
#include <cstdio>
#include <cstdint>
namespace cg = cooperative_groups;

namespace pg8 {
#define PG8_LAS __attribute__((address_space(3)))
typedef unsigned short bf16_t;
typedef short bf16x8 __attribute__((ext_vector_type(8)));
typedef float f32x4 __attribute__((ext_vector_type(4)));
typedef unsigned u32x4 __attribute__((ext_vector_type(4)));
typedef unsigned u32x2 __attribute__((ext_vector_type(2)));
constexpr int BM = 256, BK = 64, HALF = 128, HTB = HALF * BK * 2, STAGE_BYTES = 8 * HTB, NXCD = 8, WGM = 8;
__host__ __device__ __forceinline__ int lds_byte(int r, int c) { const int st = (r >> 4) * 2 + (c >> 5), rr = r & 15, cc = c & 31, ob = rr * 64 + cc * 2; return st * 1024 + (ob ^ (((ob >> 9) & 1) << 5)); }
__host__ __device__ __forceinline__ void stage_rc(int b, int& R, int& C) { const int st = b / 1024, sb = b % 1024, swz = sb ^ (((sb >> 9) & 1) << 5); R = (st >> 1) * 16 + swz / 64; C = (st & 1) * 32 + (swz % 64) / 2; }
__host__ __device__ __forceinline__ int perm32(int rho) { const int n = rho >> 4, i = rho & 15; return 8 * (i >> 2) + 4 * n + (i & 3); }

struct Unit { int pm, pn; };
struct Gemm { const bf16_t* A; const bf16_t* Bt; int M, N, K; };

struct StaticOrder {
    int nM, nN, nwg, G, c;
    __host__ __device__ void init(int M, int N, int G_, int c_) { nM = M / BM; nN = N / BM; nwg = nM * nN; G = G_; c = c_; }
    __host__ __device__ bool next(int i, Unit& u) const {
        const long L = (long)i * G + c; if (L >= nwg) return false;
        int wgid = (int)L; { const int q = nwg / NXCD, r = nwg % NXCD, xcd = wgid % NXCD, off = wgid / NXCD; wgid = (xcd < r ? xcd * (q + 1) : r * (q + 1) + (xcd - r) * q) + off; }
        const int nig = WGM * nN, gid = wgid / nig, fm = gid * WGM, gsz = (nM - fm) < WGM ? (nM - fm) : WGM;
        u.pm = fm + ((wgid % nig) % gsz); u.pn = (wgid % nig) / gsz; return true;
    }
    __device__ __forceinline__ void a_ready(const Unit&) const {}
    __device__ __forceinline__ void done(const Unit&) const {}
};
__device__ __forceinline__ unsigned cvt_pk_bf16(float lo, float hi) { unsigned r; asm volatile("v_cvt_pk_bf16_f32 %0, %1, %2" : "=v"(r) : "v"(lo), "v"(hi)); return r; }
__device__ __forceinline__ float bflo(unsigned w) { return __uint_as_float(w << 16); }
__device__ __forceinline__ float bfhi(unsigned w) { return __uint_as_float(w & 0xffff0000u); }
__device__ __forceinline__ float sigm(float x) { return __builtin_amdgcn_rcpf(1.0f + __expf(-x)); }
struct EpiBf16 {
    static constexpr bool PERM = true, AFTER_DRAIN = false;
    bf16_t* O; int ldc;
    __device__ __forceinline__ void operator()(const f32x4 (&acc)[2][2][4][2], const Unit& u, int wr, int wc, int fr, int fq) const {
        const int row0 = u.pm * BM + wr * 64 + fr, col0 = u.pn * BM + wc * 32 + 8 * fq;
#pragma unroll
        for (int ai = 0; ai < 2; ++ai)
#pragma unroll
            for (int m = 0; m < 4; ++m) { bf16_t* rowp = O + (size_t)(row0 + ai * HALF + m * 16) * ldc + col0;
#pragma unroll
                for (int bj = 0; bj < 2; ++bj) { const f32x4 v0 = acc[ai][bj][m][0], v1 = acc[ai][bj][m][1];
                    u32x4 w; w.x = cvt_pk_bf16(v0[0], v0[1]); w.y = cvt_pk_bf16(v0[2], v0[3]); w.z = cvt_pk_bf16(v1[0], v1[1]); w.w = cvt_pk_bf16(v1[2], v1[3]);
                    *(u32x4*)(rowp + bj * HALF) = w; } }
    }
};
struct EpiGate1 {
    static constexpr bool PERM = false, AFTER_DRAIN = false;
    float* Y1; int ldc; const bf16_t* bg; int ldg;
    __device__ __forceinline__ void operator()(const f32x4 (&acc)[2][2][4][2], const Unit& u, int wr, int wc, int fr, int fq) const {
        const int row0 = u.pm * BM + wr * 64 + fr, col0 = u.pn * BM + wc * 32 + 4 * fq;
#pragma unroll
        for (int ai = 0; ai < 2; ++ai)
#pragma unroll
            for (int m = 0; m < 4; ++m) { const size_t r = (size_t)(row0 + ai * HALF + m * 16);
#pragma unroll
                for (int bj = 0; bj < 2; ++bj)
#pragma unroll
                    for (int n = 0; n < 2; ++n) { const int c = col0 + bj * HALF + n * 16; const u32x2 gw = *(const u32x2*)(bg + r * ldg + c); const f32x4 a = acc[ai][bj][m][n];
                        f32x4 o; o[0] = sigm(bflo(gw.x)) * a[0]; o[1] = sigm(bfhi(gw.x)) * a[1]; o[2] = sigm(bflo(gw.y)) * a[2]; o[3] = sigm(bfhi(gw.y)) * a[3];
                        *(f32x4*)(Y1 + r * ldc + c) = o; } }
    }
};
struct EpiGate2 {
    static constexpr bool PERM = false, AFTER_DRAIN = false;
    const float* Y1; bf16_t* Y; int ldc; const bf16_t* bg; int ldg;
    __device__ __forceinline__ void operator()(const f32x4 (&acc)[2][2][4][2], const Unit& u, int wr, int wc, int fr, int fq) const {
        const int row0 = u.pm * BM + wr * 64 + fr, col0 = u.pn * BM + wc * 32 + 4 * fq;
#pragma unroll
        for (int ai = 0; ai < 2; ++ai)
#pragma unroll
            for (int m = 0; m < 4; ++m) { const size_t r = (size_t)(row0 + ai * HALF + m * 16);
#pragma unroll
                for (int bj = 0; bj < 2; ++bj)
#pragma unroll
                    for (int n = 0; n < 2; ++n) { const int c = col0 + bj * HALF + n * 16; const u32x2 gw = *(const u32x2*)(bg + r * ldg + c); const f32x4 a = acc[ai][bj][m][n];
                        const f32x4 y1 = *(const f32x4*)(Y1 + r * ldc + c);
                        u32x2 w; w.x = cvt_pk_bf16(y1[0] + sigm(bflo(gw.x)) * a[0], y1[1] + sigm(bfhi(gw.x)) * a[1]); w.y = cvt_pk_bf16(y1[2] + sigm(bflo(gw.y)) * a[2], y1[3] + sigm(bfhi(gw.y)) * a[3]);
                        *(u32x2*)(Y + r * ldc + c) = w; } }
    }
};
struct EpiRes {
    static constexpr bool PERM = false, AFTER_DRAIN = false;
    const float* X; float* H; int ldc; const float* g1;
    __device__ __forceinline__ void operator()(const f32x4 (&acc)[2][2][4][2], const Unit& u, int wr, int wc, int fr, int fq) const {
        const int row0 = u.pm * BM + wr * 64 + fr, col0 = u.pn * BM + wc * 32 + 4 * fq;
#pragma unroll
        for (int ai = 0; ai < 2; ++ai)
#pragma unroll
            for (int m = 0; m < 4; ++m) { const size_t r = (size_t)(row0 + ai * HALF + m * 16);
#pragma unroll
                for (int bj = 0; bj < 2; ++bj)
#pragma unroll
                    for (int n = 0; n < 2; ++n) { const int c = col0 + bj * HALF + n * 16; const f32x4 gv = *(const f32x4*)(g1 + c); const f32x4 xv = *(const f32x4*)(X + r * ldc + c);
                        *(f32x4*)(H + r * ldc + c) = xv + gv * acc[ai][bj][m][n]; } }
    }
};
template <class Epi, class Sched>
__device__ __forceinline__ void gemm_phase(PG8_LAS unsigned char* lds, const Gemm g, const Sched& S, const Epi& E) {
    const int tid = threadIdx.x, wid = __builtin_amdgcn_readfirstlane(tid >> 6), lane = tid & 63, wr = wid >> 2, wc = wid & 3, fr = lane & 15, fq = lane >> 4;
    const int K = g.K, nt = K / BK;
    unsigned voffA[2], voffB[2];
#pragma unroll
    for (int i = 0; i < 2; ++i) { int R, C; stage_rc(tid * 16 + i * 8192, R, C); const int Rb = Epi::PERM ? ((R & ~31) + perm32(R & 31)) : R;
        voffA[i] = (unsigned)(R * K + C) * 2u; voffB[i] = (unsigned)(Rb * K + C) * 2u; }
    const size_t kstep = (size_t)(BK * 2);
    const size_t hstep = (size_t)HALF * K * 2;
    const size_t tstep = 2 * hstep;
    const unsigned ldsw = (unsigned)wid * 1024u;
    const int aoff = lds_byte(wr * 64 + fr, fq * 8), boff = lds_byte(wc * 32 + fr, fq * 8);
#define PG8_SA(b, h) (((b) * 2 + (h)) * HTB)
#define PG8_SB(b, h) ((4 + (b) * 2 + (h)) * HTB)
#define PG8_STAGE(bufoff, gbase, voff) do { _Pragma("unroll") for (int _i = 0; _i < 2; ++_i) \
        __builtin_amdgcn_global_load_lds((const unsigned*)((const char*)(gbase) + (voff)[_i]), (PG8_LAS unsigned*)(lds + (bufoff) + ldsw + _i * 8192), 16, 0, 0); } while (0)
#define PG8_LDA(dst, b, h) do { _Pragma("unroll") for (int m = 0; m < 4; ++m) _Pragma("unroll") for (int k = 0; k < 2; ++k) dst[m][k] = *(const PG8_LAS bf16x8*)(lds + PG8_SA(b, h) + aoff + m * 2048 + k * 1024); } while (0)
#define PG8_LDB(dst, b, h) do { _Pragma("unroll") for (int n = 0; n < 2; ++n) _Pragma("unroll") for (int k = 0; k < 2; ++k) dst[n][k] = *(const PG8_LAS bf16x8*)(lds + PG8_SB(b, h) + boff + n * 2048 + k * 1024); } while (0)
#define PG8_MMA(ai, bj, At, Bt) do { __builtin_amdgcn_s_setprio(1); _Pragma("unroll") for (int m = 0; m < 4; ++m) _Pragma("unroll") for (int n = 0; n < 2; ++n) _Pragma("unroll") for (int k = 0; k < 2; ++k) \
        acc[ai][bj][m][n] = __builtin_amdgcn_mfma_f32_16x16x32_bf16(Bt[n][k], At[m][k], acc[ai][bj][m][n], 0, 0, 0); __builtin_amdgcn_s_setprio(0); } while (0)
#define PG8_WAIT_V(n) asm volatile("s_waitcnt vmcnt(" #n ")" ::: "memory")
#define PG8_WAIT_L(n) asm volatile("s_waitcnt lgkmcnt(" #n ")" ::: "memory")
#define PG8_BAR __builtin_amdgcn_s_barrier()
#define PG8_SCHED __builtin_amdgcn_sched_barrier(0)
    Unit cur, nxt; int ui = 0;
    if (!S.next(0, cur)) return;
    f32x4 acc[2][2][4][2];
#pragma unroll
    for (int a = 0; a < 2; ++a)
#pragma unroll
        for (int b = 0; b < 2; ++b)
#pragma unroll
            for (int m = 0; m < 4; ++m)
#pragma unroll
                for (int n = 0; n < 2; ++n) acc[a][b][m][n] = (f32x4){0.f, 0.f, 0.f, 0.f};
    bf16x8 At[4][2], B0[2][2], B1[2][2];
    const char* cA = (const char*)g.A + (size_t)cur.pm * tstep; const char* cB = (const char*)g.Bt + (size_t)cur.pn * tstep;
    S.a_ready(cur);
    PG8_STAGE(PG8_SB(0, 0), cB, voffB); PG8_STAGE(PG8_SA(0, 0), cA, voffA); PG8_STAGE(PG8_SB(0, 1), cB + hstep, voffB); PG8_STAGE(PG8_SA(0, 1), cA + hstep, voffA);
    if (wr == 1) PG8_BAR;
    PG8_WAIT_V(4); PG8_BAR;
    PG8_STAGE(PG8_SB(1, 0), cB + kstep, voffB); PG8_STAGE(PG8_SA(1, 0), cA + kstep, voffA); PG8_STAGE(PG8_SB(1, 1), cB + hstep + kstep, voffB);
    PG8_WAIT_V(6); PG8_BAR;
    for (;;) {
        const bool has_next = S.next(ui + 1, nxt);
        const char* nA = has_next ? (const char*)g.A + (size_t)nxt.pm * tstep : cA; const char* nB = has_next ? (const char*)g.Bt + (size_t)nxt.pn * tstep : cB;
        for (int t = 0; t < nt; t += 2) {
            const bool last = (t == nt - 2);
            const char* a1 = cA + (size_t)(t + 1) * kstep;
            const char* a2 = last ? nA : cA + (size_t)(t + 2) * kstep; const char* b2 = last ? nB : cB + (size_t)(t + 2) * kstep;
            const char* a3 = a2 + kstep; const char* b3 = b2 + kstep;
            if (last && has_next) S.a_ready(nxt);
            PG8_LDB(B0, 0, 0); PG8_SCHED; PG8_LDA(At, 0, 0); PG8_STAGE(PG8_SA(1, 1), a1 + hstep, voffA);
            PG8_WAIT_L(8); PG8_BAR; PG8_WAIT_L(0); PG8_MMA(0, 0, At, B0); PG8_BAR; PG8_SCHED;
            PG8_LDB(B1, 0, 1); PG8_STAGE(PG8_SB(0, 0), b2, voffB);
            PG8_BAR; PG8_WAIT_L(0); PG8_MMA(0, 1, At, B1); PG8_BAR;
            PG8_LDA(At, 0, 1); PG8_STAGE(PG8_SA(0, 0), a2, voffA);
            PG8_BAR; PG8_WAIT_L(0); PG8_MMA(1, 0, At, B0); PG8_BAR; PG8_SCHED;
            PG8_STAGE(PG8_SB(0, 1), b2 + hstep, voffB);
            PG8_WAIT_V(6); PG8_BAR; PG8_MMA(1, 1, At, B1); PG8_BAR;
            PG8_LDB(B0, 1, 0); PG8_SCHED; PG8_LDA(At, 1, 0); PG8_STAGE(PG8_SA(0, 1), a2 + hstep, voffA);
            PG8_WAIT_L(8); PG8_BAR; PG8_WAIT_L(0); PG8_MMA(0, 0, At, B0); PG8_BAR; PG8_SCHED;
            PG8_LDB(B1, 1, 1); PG8_STAGE(PG8_SB(1, 0), b3, voffB);
            PG8_BAR; PG8_WAIT_L(0); PG8_MMA(0, 1, At, B1); PG8_BAR;
            PG8_LDA(At, 1, 1); PG8_STAGE(PG8_SA(1, 0), a3, voffA);
            PG8_BAR; PG8_WAIT_L(0); PG8_MMA(1, 0, At, B0); PG8_BAR; PG8_SCHED;
            PG8_STAGE(PG8_SB(1, 1), b3 + hstep, voffB);
            PG8_WAIT_V(6); PG8_BAR; PG8_MMA(1, 1, At, B1); PG8_BAR;
        }
        if constexpr (!Epi::AFTER_DRAIN) { E(acc, cur, wr, wc, fr, fq); S.done(cur); }
        if (!has_next) break;
#pragma unroll
        for (int a = 0; a < 2; ++a)
#pragma unroll
            for (int b = 0; b < 2; ++b)
#pragma unroll
                for (int m = 0; m < 4; ++m)
#pragma unroll
                    for (int n = 0; n < 2; ++n) acc[a][b][m][n] = (f32x4){0.f, 0.f, 0.f, 0.f};
        cur = nxt; cA = nA; cB = nB; ++ui;
    }
    PG8_WAIT_V(0);
    if (wr == 0) PG8_BAR;
    PG8_BAR;
    if constexpr (Epi::AFTER_DRAIN) { E.fused(acc, cur, wr, wc, fr, fq, lds, wid, lane); S.done(cur); }
#undef PG8_SA
#undef PG8_SB
#undef PG8_STAGE
#undef PG8_LDA
#undef PG8_LDB
#undef PG8_MMA
#undef PG8_WAIT_V
#undef PG8_WAIT_L
#undef PG8_BAR
#undef PG8_SCHED
}
}

#define XB_TMO      128
#define XB_XCNT(j)  (256  + 64 * (j))
#define XB_XSUB(j)  (1280 + 64 * (j))
#define XB_XGEN(j)  (2304 + 64 * (j))
#define XB_TOP      3328
#define XB_TOPGEN   3392
#define XCD_BAR_WORDS 3456
#define XB_SPIN_CAP (1u << 22)
#define LAS __attribute__((address_space(3)))
__device__ __forceinline__ unsigned xb_ld(unsigned* p)              { return __hip_atomic_load(p, __ATOMIC_RELAXED, __HIP_MEMORY_SCOPE_AGENT); }
__device__ __forceinline__ unsigned xb_add(unsigned* p, unsigned v) { return __hip_atomic_fetch_add(p, v, __ATOMIC_RELAXED, __HIP_MEMORY_SCOPE_AGENT); }
__device__ __forceinline__ unsigned xb_xcc_id() { return (unsigned)__builtin_amdgcn_s_getreg((3 << 11) | 20) & 0xFu; }
#define XB_SPIN(cond, bar) do { unsigned _sp = 0; while (cond) { __builtin_amdgcn_s_sleep(1); \
    if ((++_sp & 255u) == 0u) { if (xb_ld(&(bar)[XB_TMO])) break; if (_sp > XB_SPIN_CAP) { atomicAdd(&(bar)[XB_TMO], 1u); break; } } } } while (0)
struct XcdBarrier { unsigned* bar; unsigned x; volatile LAS unsigned* st; };
__device__ __forceinline__ XcdBarrier xcd_barrier_post(unsigned* bar, volatile LAS unsigned* st) {
    XcdBarrier b; b.bar = bar; b.x = xb_xcc_id(); b.st = st;
    if (threadIdx.x == 0) (void)xb_add(&bar[XB_XCNT(b.x)], 1u);
    return b;
}
__device__ __forceinline__ void xcd_barrier_complete(unsigned* bar, unsigned x, unsigned& nloc, unsigned& nx) {
    const unsigned G = gridDim.x * gridDim.y * gridDim.z;
    unsigned sum, cnt, mine, sp = 0u;
    for (;;) {
        sum = 0u; cnt = 0u; mine = 0u;
#pragma unroll
        for (unsigned j = 0; j < 16; ++j) { const unsigned c = xb_ld(&bar[XB_XCNT(j)]); sum += c; cnt += (c > 0u) ? 1u : 0u; mine = (j == x) ? c : mine; }
        if (sum == G) break;
        __builtin_amdgcn_s_sleep(1);
        if ((++sp & 255u) == 0u) { if (xb_ld(&bar[XB_TMO])) break; if (sp > XB_SPIN_CAP) { atomicAdd(&bar[XB_TMO], 1u); break; } }
    }
    nloc = mine > 0u ? mine : 1u; nx = cnt > 0u ? cnt : 1u;
}
__device__ __forceinline__ void xcd_barrier(const XcdBarrier& b) {
    asm volatile("s_waitcnt vmcnt(0)" ::: "memory");
    __syncthreads();
    if (threadIdx.x == 0) {
        unsigned* bar = b.bar;
        __builtin_amdgcn_s_waitcnt(0);
        unsigned nloc = b.st[0], nx = b.st[1];
        if (nloc == 0u) { xcd_barrier_complete(bar, b.x, nloc, nx); b.st[0] = nloc; b.st[1] = nx; }
        const unsigned old = xb_add(&bar[XB_XSUB(b.x)], 1u);
        const unsigned gen = old / nloc;
        if (old + 1u == (gen + 1u) * nloc) {
            __builtin_amdgcn_fence(__ATOMIC_RELEASE, "agent");
            asm volatile("s_waitcnt vmcnt(0)" ::: "memory");
            const unsigned og = xb_add(&bar[XB_TOP], 1u);
            const unsigned tg = og / nx;
            if (og + 1u == (tg + 1u) * nx) xb_add(&bar[XB_TOPGEN], 1u);
            else XB_SPIN(xb_ld(&bar[XB_TOPGEN]) == tg, bar);
            __builtin_amdgcn_fence(__ATOMIC_ACQUIRE, "agent");
            xb_add(&bar[XB_XGEN(b.x)], 1u);
            asm volatile("s_waitcnt vmcnt(0)" ::: "memory");
        } else {
            XB_SPIN(xb_ld(&bar[XB_XGEN(b.x)]) == gen, bar);
            __builtin_amdgcn_fence(__ATOMIC_ACQUIRE, "agent");
            asm volatile("s_waitcnt vmcnt(0)" ::: "memory");
        }
    }
    __syncthreads();
}

typedef unsigned short bf16_t;
typedef short bf16x8 __attribute__((ext_vector_type(8)));
typedef float f32x4 __attribute__((ext_vector_type(4)));
typedef unsigned u32x4 __attribute__((ext_vector_type(4)));
typedef unsigned u32x2 __attribute__((ext_vector_type(2)));
typedef short s16x4 __attribute__((ext_vector_type(4)));
constexpr int NT = 512;
constexpr int D = 2048, L = 8192, LC = 256, LT = L + LC;
constexpr int INW = 16416;
constexpr int NREST = 10496;
constexpr int C_QK = 0, C_V = 2048, C_O = 4096, C_BGM = 6144, C_BGH = 8192, C_GT = 10240;
constexpr int NCH = 16, NCK = 33, TC = 256;
constexpr float EPS = 1e-6f;
constexpr int LDS_MAIN = 144 * 1024;
constexpr int LDS_BYTES = LDS_MAIN + 16;
#ifndef REPEAT_MASK
#define REPEAT_MASK 0
#endif
constexpr int KS = 32;
#ifndef GXV
#define GXV 2
#endif
constexpr int GX = GXV;
static_assert(GX == 2 || GX == 1, "EX_COMPUTE evaluates the gelu of exactly two experts per group");

constexpr size_t al(size_t x) { return (x + 255) & ~(size_t)255; }
constexpr size_t WS_MODP = 0;
constexpr size_t WS_MOD = WS_MODP + al((size_t)KS * 2 * 12288 * 4);
constexpr size_t WS_HDN = WS_MOD + al((size_t)2 * 12288 * 4);
constexpr size_t WS_WPM = WS_HDN + al((size_t)L * 64 * 2);
constexpr size_t WS_WPH = WS_WPM + al((size_t)D * D * 2);
constexpr size_t WS_WO = WS_WPH + al((size_t)D * D * 2);
constexpr size_t WS_WQ = WS_WO + al((size_t)D * D * 2);
constexpr size_t WS_A = WS_WQ + al((size_t)D * D * 2);
constexpr size_t WS_WREST = WS_A;
constexpr size_t WS_WHY = WS_WREST + al((size_t)NREST * D * 2);
constexpr size_t WS_A_END = WS_WHY + al((size_t)6144 * D * 2);
constexpr size_t WS_HML = WS_A;
constexpr size_t WS_HYOT = WS_HML + al((size_t)L * D * 2);
static_assert(WS_HYOT + (size_t)L * D * 2 <= WS_A_END, "region A overlay");
constexpr size_t WS_U = WS_A_END;
constexpr size_t WS_U_END = WS_U + al((size_t)LT * D * 2);
constexpr size_t WS_SPRE = WS_U;
constexpr size_t WS_VL = WS_U;
static_assert((size_t)NCH * NCK * 256 * 128 * 2 <= WS_U_END - WS_U, "SPRE overlay");
constexpr size_t WS_P1 = WS_U_END;
constexpr size_t WS_P1_END = WS_P1 + al((size_t)LT * NREST * 2);
constexpr size_t WS_HYT = WS_P1_END;
constexpr size_t WS_HYT_END = WS_HYT + al((size_t)6144 * L * 2);
constexpr size_t WS_HLAT = WS_HYT;
static_assert((size_t)L * D * 4 <= WS_HYT_END - WS_HYT, "HLAT overlay");
constexpr size_t WS_QK = WS_HYT_END;
constexpr size_t WS_QP = WS_QK;
constexpr size_t WS_G = WS_QK + al((size_t)LT * D * 2);
constexpr size_t WS_GB = WS_G, WS_GA = WS_GB + al((size_t)NCH * LT * 4), WS_GM = WS_GA + al((size_t)NCH * LT * 4);
constexpr size_t WS_SLOC = WS_GM + al((size_t)NCH * LT * 4);
constexpr size_t WS_SLOC_END = WS_SLOC + al((size_t)NCH * NCK * 256 * 128 * 4);
constexpr size_t WS_Y1 = WS_SLOC;
constexpr size_t WS_NLOC = WS_SLOC_END;
constexpr size_t WS_NPRE = WS_NLOC + al((size_t)NCH * NCK * 128 * 4);
constexpr size_t WS_MLOC = WS_NPRE + al((size_t)NCH * NCK * 128 * 4);
constexpr size_t WS_MPRE = WS_MLOC + al((size_t)NCH * NCK * 4);
constexpr size_t WS_HYO = WS_MPRE + al((size_t)NCH * NCK * 4);
constexpr size_t WS_Y = WS_HYO + al((size_t)L * D * 2);
constexpr size_t WS_YEND = WS_Y + al((size_t)L * D * 2);
constexpr size_t WS_FILT = WS_SLOC;
static_assert(WS_FILT + (size_t)8192 * 8192 * 2 <= WS_YEND, "FILT overlay");
constexpr size_t WS_BAR = WS_YEND;
constexpr size_t WS_KEYB = WS_BAR + al((size_t)XCD_BAR_WORDS * 4);
constexpr size_t WS_PU = WS_KEYB + al((size_t)8 * 2 * 128 * 128 * 2);
constexpr size_t WS_PSU = WS_PU + al((size_t)16384 * D);
constexpr size_t WS_PSV = WS_PSU + al((size_t)16384 * 4);
constexpr size_t WS_END = WS_PSV + al((size_t)16384 * 4);
constexpr size_t WS_PV = WS_HYT + al((size_t)L * D * 4);
static_assert(WS_PV + (size_t)16384 * D <= WS_HYT_END, "V table tail overlay");
static_assert(WS_END <= (size_t)643323008, "workspace map must stay within sum(inputs) bytes, the guaranteed minimum");

struct Params {
    const float *x, *c, *ctx, *c_ctx, *w_mod, *b_mod, *norm1_g, *norm2_g, *final_g, *w_in, *ml_conv_w, *ml_gate_b, *ml_norm_g, *hy_conv_w,
        *hy_w1, *hy_b1, *hy_w2, *hy_b2, *hy_w3, *hy_freq, *hy_bias, *w_proj_ml, *w_proj_hy, *w_out, *peer_wq, *peer_keys, *peer_u, *peer_v;
    float* out; unsigned char* ws;
    int ph_lo, ph_hi;
};

__device__ __forceinline__ int otid() { int t = threadIdx.x; asm volatile("" : "+v"(t)); return t; }
__device__ __forceinline__ bf16_t f2bf(float f) { unsigned u = __float_as_uint(f); u += 0x7FFFu + ((u >> 16) & 1u); return (bf16_t)(u >> 16); }
__device__ __forceinline__ float bf2f(bf16_t b) { return __uint_as_float(((unsigned)b) << 16); }
__device__ __forceinline__ unsigned pk2(float lo, float hi) { return (unsigned)f2bf(lo) | ((unsigned)f2bf(hi) << 16); }
__device__ __forceinline__ float blo(unsigned w) { return __uint_as_float(w << 16); }
__device__ __forceinline__ float bhi(unsigned w) { return __uint_as_float(w & 0xffff0000u); }
__device__ __forceinline__ float sigmoidf_(float x) { return __builtin_amdgcn_rcpf(1.0f + __expf(-x)); }
__device__ __forceinline__ float siluf_(float x) { return x * __builtin_amdgcn_rcpf(1.0f + __expf(-x)); }
__device__ __forceinline__ float wave_sum(float v) {
#pragma unroll
    for (int o = 32; o >= 1; o >>= 1) v += __shfl_xor(v, o);
    return v;
}
__device__ __forceinline__ f32x4 mfma16(bf16x8 a, bf16x8 b, f32x4 c) { return __builtin_amdgcn_mfma_f32_16x16x32_bf16(a, b, c, 0, 0, 0); }

__device__ __forceinline__ void p0_gemv_hdn(const Params& p, unsigned char* lds) {
    const int tid = otid();
    float* MODP = (float*)(p.ws + WS_MODP);
    const int gthreads = gridDim.x * NT;
    for (int item = blockIdx.x * NT + tid; item < KS * 3072; item += gthreads) {
        const int ks = item / 3072, cg4 = item % 3072;
        f32x4 a0 = {0.f, 0.f, 0.f, 0.f}, a1 = {0.f, 0.f, 0.f, 0.f};
        const int k0 = ks * (D / KS);
        for (int k = k0; k < k0 + D / KS; ++k) {
            const f32x4 w = *(const f32x4*)(p.w_mod + (size_t)k * 12288 + cg4 * 4);
            const float s0 = siluf_(p.c[k]), s1 = siluf_(p.c_ctx[k]);
            a0 += w * s0; a1 += w * s1;
        }
        *(f32x4*)(MODP + ((size_t)(ks * 2 + 0) * 12288) + cg4 * 4) = a0;
        *(f32x4*)(MODP + ((size_t)(ks * 2 + 1) * 12288) + cg4 * 4) = a1;
    }
    bf16_t* HDN = (bf16_t*)(p.ws + WS_HDN);
    float* h1s = (float*)lds;
    const int tt = tid >> 6, j = tid & 63;
    for (int u = blockIdx.x; u < L / 8; u += gridDim.x) {
        const int t = u * 8 + tt;
        const float tn = (float)t / (float)L;
        float s = p.hy_b1[j] + tn * p.hy_w1[j];
#pragma unroll
        for (int b = 0; b < 8; ++b) {
            const float band = 1e-4f + (7.0f - 1e-4f) * (float)b / 7.0f;
            const float ang = (6.283185307179586f / (float)L) * (float)t * band;
            float sn, cs; __sincosf(ang, &sn, &cs);
            s += cs * p.hy_w1[(1 + b) * 64 + j] - sn * p.hy_w1[(9 + b) * 64 + j];
        }
        const float fr = p.hy_freq[j];
        __syncthreads();
        h1s[tt * 64 + j] = __sinf(fr * s);
        __syncthreads();
        float s2 = p.hy_b2[j];
        for (int i = 0; i < 64; ++i) s2 += h1s[tt * 64 + i] * p.hy_w2[i * 64 + j];
        HDN[(size_t)t * 64 + j] = f2bf(__sinf(fr * s2));
    }
    __syncthreads();
}

struct TGroup { const float* src; int ld, k0, n0; bf16_t* dst; };
__device__ __forceinline__ TGroup p1_group(const Params& p, int tix) {
    const int NG_IN = 256 * 8, NG_SQ = 32 * 8;
    TGroup g;
    if (tix < NG_IN) {
        const int ct = tix >> 3, kg = tix & 7;
        const int dc = ct * 64;
        g.src = p.w_in; g.ld = INW; g.k0 = kg * 256;
        if (dc < 6144) { g.n0 = dc; g.dst = (bf16_t*)(p.ws + WS_WREST) + (size_t)dc * D; }
        else if (dc < 10240) { g.n0 = 12320 + (dc - 6144); g.dst = (bf16_t*)(p.ws + WS_WREST) + (size_t)dc * D; }
        else { g.n0 = 6176 + (dc - 10240); g.dst = (bf16_t*)(p.ws + WS_WHY) + (size_t)(dc - 10240) * D; }
    } else {
        const int q = tix - NG_IN, wsel = q / NG_SQ, r = q % NG_SQ, ct = r >> 3, kg = r & 7;
        g.src = wsel == 0 ? p.w_proj_ml : wsel == 1 ? p.w_proj_hy : wsel == 2 ? p.w_out : p.peer_wq; g.ld = D; g.k0 = kg * 256; g.n0 = ct * 64;
        g.dst = (bf16_t*)(p.ws + (wsel == 0 ? WS_WPM : wsel == 1 ? WS_WPH : wsel == 2 ? WS_WO : WS_WQ)) + (size_t)ct * 64 * D;
    }
    return g;
}
__device__ __forceinline__ void tg_load(const TGroup& g, int tid, f32x4 (&v)[4][2]) {
#pragma unroll
    for (int q = 0; q < 4; ++q)
#pragma unroll
        for (int i = 0; i < 2; ++i) { const int r = (tid >> 4) + 32 * i, c4 = tid & 15; v[q][i] = *(const f32x4*)(g.src + (size_t)(g.k0 + q * 64 + r) * g.ld + g.n0 + c4 * 4); }
}
__device__ __forceinline__ void tg_store(const TGroup& g, int tid, const f32x4 (&v)[4][2], unsigned char* lds) {
    float* T = (float*)lds;
#pragma unroll
    for (int q = 0; q < 4; ++q)
#pragma unroll
        for (int i = 0; i < 2; ++i) { const int r = (tid >> 4) + 32 * i, c4 = tid & 15; float* t = T + q * 64 * 65 + r * 65 + c4 * 4;
            t[0] = v[q][i][0]; t[1] = v[q][i][1]; t[2] = v[q][i][2]; t[3] = v[q][i][3]; }
    __syncthreads();
    {
        const int n = tid >> 3, k8 = tid & 7;
#pragma unroll
        for (int q = 0; q < 4; ++q) {
            const float* t = T + q * 64 * 65;
            u32x4 w;
            w.x = pk2(t[(k8 * 8 + 0) * 65 + n], t[(k8 * 8 + 1) * 65 + n]); w.y = pk2(t[(k8 * 8 + 2) * 65 + n], t[(k8 * 8 + 3) * 65 + n]);
            w.z = pk2(t[(k8 * 8 + 4) * 65 + n], t[(k8 * 8 + 5) * 65 + n]); w.w = pk2(t[(k8 * 8 + 6) * 65 + n], t[(k8 * 8 + 7) * 65 + n]);
            *(u32x4*)(g.dst + (size_t)n * D + g.k0 + q * 64 + k8 * 8) = w;
        }
    }
    __syncthreads();
}
__device__ __forceinline__ void p1_weights(const Params& p, unsigned char* lds) {
    const int tid = otid();
    if (blockIdx.x < 48) {
        const int n = blockIdx.x * NT + tid; const int v = n / 12288, nn = n % 12288;
        const float* MODP = (const float*)(p.ws + WS_MODP);
        float s = p.b_mod[nn];
        for (int ks = 0; ks < KS; ++ks) s += MODP[(size_t)(ks * 2 + v) * 12288 + nn];
        ((float*)(p.ws + WS_MOD))[n] = s;
    }
    const int NG = 256 * 8 + 4 * 32 * 8;
    {
        f32x4 va[4][2], vb[4][2];
        int tix = blockIdx.x;
        TGroup ga = p1_group(p, tix < NG ? tix : 0), gb = ga;
        if (tix < NG) tg_load(ga, tid, va);
#pragma unroll 1
        for (; tix < NG; tix += 2 * gridDim.x) {
            const int t2 = tix + gridDim.x, t3 = tix + 2 * gridDim.x;
            if (t2 < NG) { gb = p1_group(p, t2); tg_load(gb, tid, vb); }
            tg_store(ga, tid, va, lds);
            if (t3 < NG) { ga = p1_group(p, t3); tg_load(ga, tid, va); }
            if (t2 < NG) tg_store(gb, tid, vb, lds);
        }
    }
    for (int item = blockIdx.x * NT + tid; item < 32 * D; item += gridDim.x * NT) {
        const int k = item >> 5, j = item & 31;
        ((bf16_t*)(p.ws + WS_WREST))[(size_t)(C_GT + j) * D + k] = f2bf(p.w_in[(size_t)k * INW + 6144 + j]);
    }
}

__device__ __forceinline__ void p1_filters(const Params& p) {
    const int tid = otid(), lane = tid & 63, wv = tid >> 6, fr = lane & 15, fq = lane >> 4;
    const bf16_t* HDN = (const bf16_t*)(p.ws + WS_HDN);
    bf16_t* FILT = (bf16_t*)(p.ws + WS_FILT);
    const float dmin = -3.0701134573253944f, dmax = -15.350567286626972f;
    for (int task = blockIdx.x * 8 + wv; task < 512 * 8; task += gridDim.x * 8) {
        const int cgp = task >> 3, tpart = task & 7;
        const int col = cgp * 16 + fr;
        bf16x8 bw[2];
#pragma unroll
        for (int kk = 0; kk < 2; ++kk)
#pragma unroll
            for (int e = 0; e < 8; ++e) bw[kk][e] = (short)f2bf(p.hy_w3[(size_t)(kk * 32 + fq * 8 + e) * 8192 + col]);
        const float delta = fabsf(dmin + (dmax - dmin) * (float)(col & 2047) / 2047.0f);
#pragma unroll 1
        for (int tt0 = 0; tt0 < 64; tt0 += 8) {
            bf16x8 af[8][2];
#pragma unroll
            for (int q = 0; q < 8; ++q)
#pragma unroll
                for (int kk = 0; kk < 2; ++kk) af[q][kk] = *(const bf16x8*)(HDN + (size_t)((tpart * 64 + tt0 + q) * 16 + fr) * 64 + kk * 32 + fq * 8);
#pragma unroll
            for (int q = 0; q < 8; ++q) {
                f32x4 acc = {0.f, 0.f, 0.f, 0.f};
                acc = mfma16(af[q][0], bw[0], acc); acc = mfma16(af[q][1], bw[1], acc);
                const int t0 = (tpart * 64 + tt0 + q) * 16 + fq * 4;
                float v[4];
#pragma unroll
                for (int j = 0; j < 4; ++j) v[j] = acc[j] * (__expf(-((float)(t0 + j) / (float)L) * delta) + 0.05f);
                u32x2 w; w.x = pk2(v[0], v[1]); w.y = pk2(v[2], v[3]);
                *(u32x2*)(FILT + (size_t)col * 8192 + t0) = w;
            }
        }
    }
}

template <int MODE>
__device__ __forceinline__ void p_rownorm(const Params& p) {
    const int tid = otid(), lane = tid & 63, wv = tid >> 6;
    const float* MOD = (const float*)(p.ws + WS_MOD);
    const int nrows = MODE == 0 ? LT : L;
    bf16_t* O = (bf16_t*)(p.ws + (MODE == 0 ? WS_U : WS_VL));
    const float* gn = MODE == 0 ? p.norm1_g : p.norm2_g;
    for (int row = blockIdx.x * 8 + wv; row < nrows; row += gridDim.x * 8) {
        const float* src = MODE == 0 ? (row < L ? p.x + (size_t)row * D : p.ctx + (size_t)(row - L) * D) : (const float*)(p.ws + WS_HLAT) + (size_t)row * D;
        const float* md = MOD + ((MODE == 0 && row >= L) ? 12288 : 0) + (MODE == 0 ? 0 : 3 * D);
        f32x4 v[8]; float ss = 0.f;
#pragma unroll
        for (int i = 0; i < 8; ++i) { v[i] = *(const f32x4*)(src + (lane + 64 * i) * 4); ss += v[i][0] * v[i][0] + v[i][1] * v[i][1] + v[i][2] * v[i][2] + v[i][3] * v[i][3]; }
        ss = wave_sum(ss);
        const float rinv = rsqrtf(ss * (1.0f / D) + EPS);
#pragma unroll
        for (int i = 0; i < 8; ++i) {
            const int c = (lane + 64 * i) * 4;
            const f32x4 g = *(const f32x4*)(gn + c), sh = *(const f32x4*)(md + c), sc = *(const f32x4*)(md + D + c);
            const f32x4 y = v[i] * rinv * g * (sc + 1.0f) + sh;
            u32x2 w; w.x = pk2(y[0], y[1]); w.y = pk2(y[2], y[3]);
            *(u32x2*)(O + (size_t)row * D + c) = w;
        }
    }
}

__device__ __forceinline__ void mini_gemm_task(const bf16_t* A, const bf16_t* Bt, bf16_t* O, unsigned char* lds) {
    const int tid = otid(), lane = tid & 63, wv = tid >> 6, fr = lane & 15, fq = lane >> 4;
    f32x4 acc[4][4];
#pragma unroll
    for (int m = 0; m < 4; ++m)
#pragma unroll
        for (int n = 0; n < 4; ++n) acc[m][n] = (f32x4){0.f, 0.f, 0.f, 0.f};
#pragma unroll 1
    for (int ks = 0; ks < 8; ks += 2) {
        bf16x8 af[2][4], bfr[2][4];
#pragma unroll
        for (int u = 0; u < 2; ++u)
#pragma unroll
            for (int m = 0; m < 4; ++m) { const int k = wv * 256 + (ks + u) * 32 + fq * 8;
                af[u][m] = *(const bf16x8*)(A + (size_t)(m * 16 + fr) * D + k); bfr[u][m] = *(const bf16x8*)(Bt + (size_t)(m * 16 + fr) * D + k); }
#pragma unroll
        for (int u = 0; u < 2; ++u)
#pragma unroll
            for (int m = 0; m < 4; ++m)
#pragma unroll
                for (int n = 0; n < 4; ++n) acc[m][n] = mfma16(af[u][m], bfr[u][n], acc[m][n]);
    }
    float* red = (float*)lds;
    __syncthreads();
#pragma unroll
    for (int m = 0; m < 4; ++m)
#pragma unroll
        for (int n = 0; n < 4; ++n) *(f32x4*)(red + (((size_t)wv * 16 + m * 4 + n) * 64 + lane) * 4) = acc[m][n];
    __syncthreads();
#pragma unroll
    for (int i = 0; i < 2; ++i) {
        const int g = tid + NT * i, tile = g >> 6, ln = g & 63, m = tile >> 2, n = tile & 3;
        f32x4 sum = {0.f, 0.f, 0.f, 0.f};
#pragma unroll
        for (int w = 0; w < 8; ++w) sum += *(const f32x4*)(red + (((size_t)w * 16 + tile) * 64 + ln) * 4);
#pragma unroll
        for (int j = 0; j < 4; ++j) O[(size_t)(m * 16 + (ln >> 4) * 4 + j) * NREST + n * 16 + (ln & 15)] = f2bf(sum[j]);
    }
    __syncthreads();
}
__device__ __forceinline__ void p3_side_tasks(const Params& p, unsigned char* lds) {
    const bf16_t* U = (const bf16_t*)(p.ws + WS_U); const bf16_t* W = (const bf16_t*)(p.ws + WS_WREST); bf16_t* P1 = (bf16_t*)(p.ws + WS_P1);
    for (int task = blockIdx.x; task < 256 + 132; task += gridDim.x) {
        if (task < 256) { const int rb = task >> 6, cb = task & 63;
            mini_gemm_task(U + (size_t)(L + rb * 64) * D, W + (size_t)(cb * 64) * D, P1 + (size_t)(L + rb * 64) * NREST + cb * 64, lds); }
        else { const int rb = task - 256;
            mini_gemm_task(U + (size_t)(rb * 64) * D, W + (size_t)C_GT * D, P1 + (size_t)(rb * 64) * NREST + C_GT, lds); }
    }
}

__device__ __forceinline__ int pos_row(int dir, int pos) {
    return dir == 0 ? (pos < LC ? L + pos : pos - LC) : (pos < LC ? L + (LC - 1 - pos) : (L - 1) - (pos - LC));
}
__device__ __forceinline__ float logsigmoidf_(float x) { return fminf(x, 0.f) - log1pf(__expf(-fabsf(x))); }
__device__ __forceinline__ void p4_conv_gates(const Params& p, unsigned char* lds) {
    const int tid = otid(), lane = tid & 63;
    const bf16_t* P1 = (const bf16_t*)(p.ws + WS_P1);
    bf16_t* QK = (bf16_t*)(p.ws + WS_QK);
    if (blockIdx.x < NCH) {
        const int chain = blockIdx.x, dir = chain >> 3, head = chain & 7, wv = tid >> 6;
        float* GB = (float*)(p.ws + WS_GB) + (size_t)chain * LT; float* GA = (float*)(p.ws + WS_GA) + (size_t)chain * LT; float* GM = (float*)(p.ws + WS_GM) + (size_t)chain * LT;
        const float bi = p.ml_gate_b[(dir * 2) * 8 + head], bfg = p.ml_gate_b[(dir * 2 + 1) * 8 + head];
        const int ci = C_GT + (dir * 2) * 8 + head, cfc = C_GT + (dir * 2 + 1) * 8 + head;
        float* red = (float*)lds;
        constexpr int SEG = 17;
        const int p0 = tid * SEG;
        float gf[SEG], ga[SEG];
        float lsum = 0.f;
#pragma unroll
        for (int i = 0; i < SEG; ++i) {
            const int pos = p0 + i; const bool ok = pos < LT; const int r = pos_row(dir, ok ? pos : 0);
            gf[i] = ok ? logsigmoidf_(bf2f(P1[(size_t)r * NREST + cfc]) + bfg) : 0.f;
            ga[i] = ok ? bf2f(P1[(size_t)r * NREST + ci]) + bi : -1e30f;
            lsum += gf[i];
        }
        float incl = lsum;
#pragma unroll
        for (int o = 1; o < 64; o <<= 1) { const float t = __shfl_up(incl, o); if (lane >= o) incl += t; }
        __syncthreads();
        if (lane == 63) red[wv] = incl;
        __syncthreads();
        float woff = 0.f;
        for (int i = 0; i < wv; ++i) woff += red[i];
        float run = woff + incl - lsum, lmax = -1e30f;
#pragma unroll
        for (int i = 0; i < SEG; ++i) {
            const int pos = p0 + i;
            run += gf[i];
            ga[i] = ga[i] - run;
            if (pos < LT) { GB[pos] = run; GA[pos] = ga[i]; lmax = fmaxf(lmax, ga[i]); }
        }
        float imax = lmax;
#pragma unroll
        for (int o = 1; o < 64; o <<= 1) { const float t = __shfl_up(imax, o); if (lane >= o) imax = fmaxf(imax, t); }
        __syncthreads();
        if (lane == 63) red[wv] = imax;
        __syncthreads();
        float pm = __shfl_up(imax, 1); if (lane == 0) pm = -1e30f;
        for (int i = 0; i < wv; ++i) pm = fmaxf(pm, red[i]);
#pragma unroll
        for (int i = 0; i < SEG; ++i) { const int pos = p0 + i; if (pos < LT) { pm = fmaxf(pm, ga[i]); GM[pos] = pm; } }
        __syncthreads();
    }
    const float qs = 0.08838834764831845f;
    for (int g = blockIdx.x * NT + tid; g < 256 * 64 * 8; g += gridDim.x * NT) {
        const int c8 = (g & 255) * 8, gc = (g >> 8) & 63, seg = g >> 14;
        float w[9][8];
#pragma unroll
        for (int k = 0; k < 9; ++k) { const f32x4 w0 = *(const f32x4*)(p.ml_conv_w + (size_t)k * D + c8), w1 = *(const f32x4*)(p.ml_conv_w + (size_t)k * D + c8 + 4);
            w[k][0] = w0[0]; w[k][1] = w0[1]; w[k][2] = w0[2]; w[k][3] = w0[3]; w[k][4] = w1[0]; w[k][5] = w1[1]; w[k][6] = w1[2]; w[k][7] = w1[3]; }
        const float sc = c8 < 1024 ? qs : 1.0f;
        u32x4 win[3][3];
        const u32x4 zero4 = {0u, 0u, 0u, 0u};
#define CV_LOAD(slot_, r_) do { _Pragma("unroll") for (int dc = 0; dc < 3; ++dc) { const int c2_ = gc + dc - 1; const bool ok_ = (r_) >= 0 && (r_) < 128 && c2_ >= 0 && c2_ < 64; \
            win[slot_][dc] = ok_ ? *(const u32x4*)(P1 + (size_t)((r_) * 64 + c2_) * NREST + C_QK + c8) : zero4; } } while (0)
        const int r0 = seg * 16;
        CV_LOAD(0, r0 - 1); CV_LOAD(1, r0);
#pragma unroll 1
        for (int rr = 0; rr < 16; rr += 3) {
#pragma unroll
            for (int ph = 0; ph < 3; ++ph) {
                const int r = r0 + rr + ph;
                if (rr + ph < 16) {
                    CV_LOAD((ph + 2) % 3, r + 1);
                    float acc[8];
#pragma unroll
                    for (int e = 0; e < 8; ++e) acc[e] = 0.f;
#pragma unroll
                    for (int dr = 0; dr < 3; ++dr)
#pragma unroll
                        for (int dc = 0; dc < 3; ++dc) {
                            const u32x4 v = win[(ph + dr) % 3][dc]; const int k = dr * 3 + dc;
                            acc[0] += blo(v.x) * w[k][0]; acc[1] += bhi(v.x) * w[k][1]; acc[2] += blo(v.y) * w[k][2]; acc[3] += bhi(v.y) * w[k][3];
                            acc[4] += blo(v.z) * w[k][4]; acc[5] += bhi(v.z) * w[k][5]; acc[6] += blo(v.w) * w[k][6]; acc[7] += bhi(v.w) * w[k][7];
                        }
                    u32x4 o;
                    o.x = pk2(siluf_(acc[0]) * sc, siluf_(acc[1]) * sc); o.y = pk2(siluf_(acc[2]) * sc, siluf_(acc[3]) * sc);
                    o.z = pk2(siluf_(acc[4]) * sc, siluf_(acc[5]) * sc); o.w = pk2(siluf_(acc[6]) * sc, siluf_(acc[7]) * sc);
                    *(u32x4*)(QK + (size_t)(r * 64 + gc) * D + c8) = o;
                }
            }
        }
    }
    for (int item = blockIdx.x * NT + tid; item < LC * 256; item += gridDim.x * NT) {
        const int i0 = item >> 8, c8 = (item & 255) * 8;
        float acc[8];
#pragma unroll
        for (int e = 0; e < 8; ++e) acc[e] = 0.f;
#pragma unroll
        for (int dc = 0; dc < 3; ++dc) {
            const int i2 = i0 + dc - 1;
            if (i2 < 0 || i2 >= LC) continue;
            const u32x4 v = *(const u32x4*)(P1 + (size_t)(L + i2) * NREST + C_QK + c8);
            const f32x4 w0 = *(const f32x4*)(p.ml_conv_w + (size_t)(3 + dc) * D + c8), w1 = *(const f32x4*)(p.ml_conv_w + (size_t)(3 + dc) * D + c8 + 4);
            acc[0] += blo(v.x) * w0[0]; acc[1] += bhi(v.x) * w0[1]; acc[2] += blo(v.y) * w0[2]; acc[3] += bhi(v.y) * w0[3];
            acc[4] += blo(v.z) * w1[0]; acc[5] += bhi(v.z) * w1[1]; acc[6] += blo(v.w) * w1[2]; acc[7] += bhi(v.w) * w1[3];
        }
        const float sc = c8 < 1024 ? qs : 1.0f;
        u32x4 w;
        w.x = pk2(siluf_(acc[0]) * sc, siluf_(acc[1]) * sc); w.y = pk2(siluf_(acc[2]) * sc, siluf_(acc[3]) * sc);
        w.z = pk2(siluf_(acc[4]) * sc, siluf_(acc[5]) * sc); w.w = pk2(siluf_(acc[6]) * sc, siluf_(acc[7]) * sc);
        *(u32x4*)(QK + (size_t)(L + i0) * D + c8) = w;
    }
}

__device__ __forceinline__ void p5_local_states(const Params& p, unsigned char* lds) {
    const int tid = otid(), lane = tid & 63, wv = tid >> 6, fr = lane & 15, fq = lane >> 4;
    const bf16_t* P1 = (const bf16_t*)(p.ws + WS_P1);
    const bf16_t* QK = (const bf16_t*)(p.ws + WS_QK);
    bf16_t* Vt = (bf16_t*)lds;
    bf16_t* Kt = (bf16_t*)(lds + 256 * 72 * 2);
    float* red = (float*)(lds + 256 * 72 * 2 + 128 * 72 * 2);
    float* wg = red + 16;
    for (int u0 = blockIdx.x; u0 < NCH * (NCK - 1); u0 += gridDim.x) {
        const int chain = u0 / (NCK - 1), c = u0 % (NCK - 1), dir = chain >> 3, head = chain & 7, u = chain * NCK + c;
        const float* GA = (const float*)(p.ws + WS_GA) + (size_t)chain * LT + c * TC;
        float a = tid < TC ? GA[tid] : -1e30f;
        float m = a;
#pragma unroll
        for (int o = 32; o >= 1; o >>= 1) m = fmaxf(m, __shfl_xor(m, o));
        __syncthreads();
        if (lane == 0) red[wv] = m;
        __syncthreads();
        float mloc = red[0];
#pragma unroll
        for (int i = 1; i < 8; ++i) mloc = fmaxf(mloc, red[i]);
        if (tid < TC) wg[tid] = __expf(a - mloc);
        f32x4 acc[2][8];
#pragma unroll
        for (int i = 0; i < 2; ++i)
#pragma unroll
            for (int j = 0; j < 8; ++j) acc[i][j] = (f32x4){0.f, 0.f, 0.f, 0.f};
        float nacc = 0.f;
        u32x4 vreg[4], kreg[2];
#define P5_FETCH(sb_) do { \
            _Pragma("unroll") for (int i = 0; i < 4; ++i) { const int item = tid + NT * i, s_ = item >> 5, v8 = item & 31; const int r = pos_row(dir, c * TC + (sb_) * 64 + s_); \
                vreg[i] = *(const u32x4*)(P1 + (size_t)r * NREST + C_V + head * 256 + v8 * 8); } \
            _Pragma("unroll") for (int i = 0; i < 2; ++i) { const int item = tid + NT * i, s_ = item >> 4, d8 = item & 15; const int r = pos_row(dir, c * TC + (sb_) * 64 + s_); \
                kreg[i] = *(const u32x4*)(QK + (size_t)r * D + 1024 + head * 128 + d8 * 8); } } while (0)
        P5_FETCH(0);
        for (int sb = 0; sb < 4; ++sb) {
            __syncthreads();
#pragma unroll
            for (int i = 0; i < 4; ++i) { const int item = tid + NT * i, s_ = item >> 5, v8 = item & 31; *(u32x4*)(Vt + s_ * 264 + v8 * 8) = vreg[i]; }
#pragma unroll
            for (int i = 0; i < 2; ++i) {
                const int item = tid + NT * i, s_ = item >> 4, d8 = item & 15;
                const u32x4 w = kreg[i];
                const float g = wg[sb * 64 + s_];
                u32x4 o; o.x = pk2(blo(w.x) * g, bhi(w.x) * g); o.y = pk2(blo(w.y) * g, bhi(w.y) * g); o.z = pk2(blo(w.z) * g, bhi(w.z) * g); o.w = pk2(blo(w.w) * g, bhi(w.w) * g);
                *(u32x4*)(Kt + s_ * 136 + d8 * 8) = o;
            }
            __syncthreads();
            if (sb < 3) P5_FETCH(sb + 1);
            if (tid < 128) { float s2 = 0.f; for (int s_ = 0; s_ < 64; ++s_) s2 += bf2f(Kt[s_ * 136 + tid]); nacc += s2; }
#pragma unroll
            for (int kk = 0; kk < 2; ++kk) {
                bf16x8 af[2], bfr[8];
                const int trow = kk * 32 + fq * 8 + ((lane & 15) >> 2), tcol = (lane & 3) * 4;
#pragma unroll
                for (int mt = 0; mt < 2; ++mt) { const bf16_t* vb = Vt + trow * 264 + wv * 32 + mt * 16 + tcol;
                    const s16x4 lo = __builtin_amdgcn_ds_read_tr16_b64_v4i16((LAS s16x4*)(vb)), hi = __builtin_amdgcn_ds_read_tr16_b64_v4i16((LAS s16x4*)(vb + 4 * 264));
                    af[mt] = (bf16x8){lo[0], lo[1], lo[2], lo[3], hi[0], hi[1], hi[2], hi[3]}; }
#pragma unroll
                for (int nt = 0; nt < 8; ++nt) { const bf16_t* kb = Kt + trow * 136 + nt * 16 + tcol;
                    const s16x4 lo = __builtin_amdgcn_ds_read_tr16_b64_v4i16((LAS s16x4*)(kb)), hi = __builtin_amdgcn_ds_read_tr16_b64_v4i16((LAS s16x4*)(kb + 4 * 136));
                    bfr[nt] = (bf16x8){lo[0], lo[1], lo[2], lo[3], hi[0], hi[1], hi[2], hi[3]}; }
#pragma unroll
                for (int mt = 0; mt < 2; ++mt)
#pragma unroll
                    for (int nt = 0; nt < 8; ++nt) acc[mt][nt] = mfma16(af[mt], bfr[nt], acc[mt][nt]);
            }
        }
        float* SL = (float*)(p.ws + WS_SLOC) + (size_t)u * 256 * 128;
#pragma unroll
        for (int mt = 0; mt < 2; ++mt)
#pragma unroll
            for (int nt = 0; nt < 8; ++nt)
#pragma unroll
                for (int j = 0; j < 4; ++j) SL[(size_t)(wv * 32 + mt * 16 + fq * 4 + j) * 128 + nt * 16 + fr] = acc[mt][nt][j];
        if (tid < 128) ((float*)(p.ws + WS_NLOC))[(size_t)u * 128 + tid] = nacc;
        if (tid == 0) ((float*)(p.ws + WS_MLOC))[u] = mloc;
    }
    __syncthreads();
}

__device__ __forceinline__ void p6_scan(const Params& p) {
    const int tid = otid();
    const float* MLOC = (const float*)(p.ws + WS_MLOC);
    constexpr int EPC = 256 * 128 + 128;
    for (int item = blockIdx.x * NT + tid; item < NCH * EPC; item += gridDim.x * NT) {
        const int chain = item / EPC, e = item % EPC;
        float S = 0.f, mrun = -1e30f;
        const bool isS = e < 256 * 128;
#pragma unroll 1
        for (int c0 = 0; c0 < NCK; c0 += 11) {
            float loc[11];
#pragma unroll
            for (int i = 0; i < 11; ++i) { const int u = chain * NCK + c0 + i;
                loc[i] = isS ? ((const float*)(p.ws + WS_SLOC))[(size_t)u * 256 * 128 + e] : ((const float*)(p.ws + WS_NLOC))[(size_t)u * 128 + (e - 256 * 128)]; }
#pragma unroll
            for (int i = 0; i < 11; ++i) {
                const int u = chain * NCK + c0 + i;
                if (isS) ((bf16_t*)(p.ws + WS_SPRE))[(size_t)u * 256 * 128 + e] = f2bf(S);
                else ((float*)(p.ws + WS_NPRE))[(size_t)u * 128 + (e - 256 * 128)] = S;
                if (e == 0) ((float*)(p.ws + WS_MPRE))[u] = mrun;
                if (c0 + i < NCK - 1) {
                    const float ml = MLOC[u];
                    const float mnew = fmaxf(mrun, ml);
                    S = S * __expf(mrun - mnew) + loc[i] * __expf(ml - mnew);
                    mrun = mnew;
                }
            }
        }
    }
}

__device__ __forceinline__ void p7_mlstm_out(const Params& p, unsigned char* lds) {
    const int tid = otid(), lane = tid & 63, wv = tid >> 6, fr = lane & 15, fq = lane >> 4;
    const bf16_t* P1 = (const bf16_t*)(p.ws + WS_P1);
    const bf16_t* QK = (const bf16_t*)(p.ws + WS_QK);
    bf16_t* Qs = (bf16_t*)lds;
    float* rowM = (float*)(lds + 64 * 136 * 2);
    float* rowB = rowM + 64;
    float* denS = rowB + 64;
    float* asS = denS + 64;
    float* npS = asS + 64;
    float* ssq = npS + 128;
    unsigned char* big = lds + 64 * 136 * 2 + 2048;
    bf16_t* Ss = (bf16_t*)big;
    bf16_t* Ks = (bf16_t*)big;
    bf16_t* Vt = (bf16_t*)(big + 64 * 136 * 2);
    bf16_t* Ps = (bf16_t*)(big + 64 * 136 * 2 + 256 * 72 * 2);
    const int rt = wv & 3, ch = wv >> 2;
    for (int u = blockIdx.x; u < 8 * 128; u += gridDim.x) {
        const int head = u >> 7, tb = u & 127;
        f32x4 hs[8];
#pragma unroll
        for (int j = 0; j < 8; ++j) hs[j] = (f32x4){0.f, 0.f, 0.f, 0.f};
        __syncthreads();
        {
#pragma unroll
            for (int i = 0; i < 2; ++i) { const int item = tid + NT * i, r = item >> 4, c8 = item & 15;
                *(u32x4*)(Qs + r * 136 + c8 * 8) = *(const u32x4*)(QK + (size_t)(tb * 64 + r) * D + head * 128 + c8 * 8); }
        }
        for (int dir = 0; dir < 2; ++dir) {
            const int chain = dir * 8 + head, pb = dir ? 131 - tb : 4 + tb, c = pb >> 2;
            const int uu = chain * NCK + c;
            const float* GA = (const float*)(p.ws + WS_GA) + (size_t)chain * LT; const float* GB = (const float*)(p.ws + WS_GB) + (size_t)chain * LT; const float* GM = (const float*)(p.ws + WS_GM) + (size_t)chain * LT;
            const float mprev = ((const float*)(p.ws + WS_MPRE))[uu];
            __syncthreads();
            if (tid < 64) { const int pos = dir ? pb * 64 + 63 - tid : pb * 64 + tid; rowM[tid] = GM[pos]; rowB[tid] = GB[pos]; }
            if (tid >= 64 && tid < 192) npS[tid - 64] = ((const float*)(p.ws + WS_NPRE))[(size_t)uu * 128 + tid - 64];
            {
                const bf16_t* SP = (const bf16_t*)(p.ws + WS_SPRE) + (size_t)uu * 256 * 128;
#pragma unroll
                for (int i = 0; i < 8; ++i) { const int item = tid + NT * i, r = item >> 4, c8 = item & 15;
                    *(u32x4*)(Ss + r * 136 + c8 * 8) = *(const u32x4*)(SP + (size_t)r * 128 + c8 * 8); }
            }
            __syncthreads();
            u32x4 kreg[2], vreg[4]; float areg = 0.f;
#define P7_FETCH(pb2_) do { const int tb2_ = dir ? 131 - (pb2_) : (pb2_) - 4; \
                _Pragma("unroll") for (int i = 0; i < 2; ++i) { const int item = tid + NT * i, r = item >> 4, c8 = item & 15; kreg[i] = *(const u32x4*)(QK + (size_t)(tb2_ * 64 + r) * D + 1024 + head * 128 + c8 * 8); } \
                _Pragma("unroll") for (int i = 0; i < 4; ++i) { const int item = tid + NT * i, s_ = item >> 5, v8 = item & 31; vreg[i] = *(const u32x4*)(P1 + (size_t)(tb2_ * 64 + s_) * NREST + C_V + head * 256 + v8 * 8); } \
                if (tid < 64) { const int pos = dir ? (pb2_) * 64 + 63 - tid : (pb2_) * 64 + tid; areg = GA[pos]; } } while (0)
            P7_FETCH(c * 4);
            f32x4 acc[8];
#pragma unroll
            for (int j = 0; j < 8; ++j) acc[j] = (f32x4){0.f, 0.f, 0.f, 0.f};
#pragma unroll
            for (int kk = 0; kk < 4; ++kk) {
                const bf16x8 af = *(const bf16x8*)(Qs + (rt * 16 + fr) * 136 + kk * 32 + fq * 8);
#pragma unroll
                for (int j = 0; j < 8; ++j) { const bf16x8 bfr = *(const bf16x8*)(Ss + (ch * 128 + j * 16 + fr) * 136 + kk * 32 + fq * 8); acc[j] = mfma16(af, bfr, acc[j]); }
            }
            {
                float sc[4];
#pragma unroll
                for (int j2 = 0; j2 < 4; ++j2) sc[j2] = __expf(mprev - rowM[rt * 16 + fq * 4 + j2]);
#pragma unroll
                for (int j = 0; j < 8; ++j)
#pragma unroll
                    for (int j2 = 0; j2 < 4; ++j2) acc[j][j2] *= sc[j2];
            }
            float den = 0.f;
            if (tid < 64) { float s = 0.f; for (int d = 0; d < 128; ++d) s += bf2f(Qs[tid * 136 + d]) * npS[d]; den = s * __expf(mprev - rowM[tid]); }
            for (int pb2 = c * 4; pb2 <= pb; ++pb2) {
                __syncthreads();
                {
#pragma unroll
                    for (int i = 0; i < 2; ++i) { const int item = tid + NT * i, r = item >> 4, c8 = item & 15; *(u32x4*)(Ks + r * 136 + c8 * 8) = kreg[i]; }
#pragma unroll
                    for (int i = 0; i < 4; ++i) { const int item = tid + NT * i, s2 = item >> 5, v8 = item & 31; *(u32x4*)(Vt + s2 * 264 + v8 * 8) = vreg[i]; }
                    if (tid < 64) asS[tid] = areg;
                }
                __syncthreads();
                if (pb2 < pb) P7_FETCH(pb2 + 1);
                {
#pragma unroll
                    for (int t2 = 0; t2 < 2; ++t2) {
                        const int st = ch * 2 + t2;
                        f32x4 pa = {0.f, 0.f, 0.f, 0.f};
#pragma unroll
                        for (int kk = 0; kk < 4; ++kk) {
                            const bf16x8 af = *(const bf16x8*)(Qs + (rt * 16 + fr) * 136 + kk * 32 + fq * 8);
                            const bf16x8 bfr = *(const bf16x8*)(Ks + (st * 16 + fr) * 136 + kk * 32 + fq * 8);
                            pa = mfma16(af, bfr, pa);
                        }
                        const int is = st * 16 + fr; const float as = asS[is];
#pragma unroll
                        for (int j2 = 0; j2 < 4; ++j2) {
                            const int it = rt * 16 + fq * 4 + j2;
                            bool ok = true;
                            if (pb2 == pb) ok = dir ? (is >= it) : (is <= it);
                            const float w = ok ? __expf(as - rowM[it]) : 0.f;
                            Ps[it * 72 + is] = f2bf(pa[j2] * w);
                        }
                    }
                }
                __syncthreads();
                if (tid < 64) { float s = 0.f; for (int i = 0; i < 64; ++i) s += bf2f(Ps[tid * 72 + i]); den += s; }
#pragma unroll
                for (int kk = 0; kk < 2; ++kk) {
                    const bf16x8 af = *(const bf16x8*)(Ps + (rt * 16 + fr) * 72 + kk * 32 + fq * 8);
#pragma unroll
                    for (int j = 0; j < 8; ++j) {
                        const bf16_t* vb = Vt + (kk * 32 + fq * 8 + ((lane & 15) >> 2)) * 264 + ch * 128 + j * 16 + (lane & 3) * 4;
                        const s16x4 lo = __builtin_amdgcn_ds_read_tr16_b64_v4i16((LAS s16x4*)(vb)), hi = __builtin_amdgcn_ds_read_tr16_b64_v4i16((LAS s16x4*)(vb + 4 * 264));
                        const bf16x8 bfr = {lo[0], lo[1], lo[2], lo[3], hi[0], hi[1], hi[2], hi[3]};
                        acc[j] = mfma16(af, bfr, acc[j]); }
                }
            }
            if (tid < 64) { const float mt = rowB[tid] + rowM[tid]; denS[tid] = 1.0f / fmaxf(fabsf(den), __expf(-mt)); }
            __syncthreads();
            {
                float dn[4];
#pragma unroll
                for (int j2 = 0; j2 < 4; ++j2) dn[j2] = denS[rt * 16 + fq * 4 + j2];
#pragma unroll
                for (int j = 0; j < 8; ++j)
#pragma unroll
                    for (int j2 = 0; j2 < 4; ++j2) hs[j][j2] += acc[j][j2] * dn[j2];
            }
        }
        {
            float s4[4] = {0.f, 0.f, 0.f, 0.f};
#pragma unroll
            for (int j = 0; j < 8; ++j)
#pragma unroll
                for (int j2 = 0; j2 < 4; ++j2) s4[j2] += hs[j][j2] * hs[j][j2];
#pragma unroll
            for (int j2 = 0; j2 < 4; ++j2) {
#pragma unroll
                for (int o = 1; o <= 8; o <<= 1) s4[j2] += __shfl_xor(s4[j2], o);
            }
            __syncthreads();
            if (fr == 0) {
#pragma unroll
                for (int j2 = 0; j2 < 4; ++j2) ssq[ch * 64 + rt * 16 + fq * 4 + j2] = s4[j2];
            }
            __syncthreads();
            bf16_t* HML = (bf16_t*)(p.ws + WS_HML);
            float* Hs = (float*)big;
#pragma unroll
            for (int j2 = 0; j2 < 4; ++j2) {
                const int it = rt * 16 + fq * 4 + j2;
                const float rinv = rsqrtf((ssq[it] + ssq[64 + it]) * (1.0f / 256.0f) + EPS);
#pragma unroll
                for (int j = 0; j < 8; ++j) Hs[it * 260 + ch * 128 + j * 16 + fr] = hs[j][j2] * rinv;
            }
            __syncthreads();
#pragma unroll
            for (int i = 0; i < 4; ++i) {
                const int item = tid + NT * i, it = item >> 5, c8 = (item & 31) * 8;
                const int trow = tb * 64 + it, col = head * 256 + c8;
                const u32x4 ow = *(const u32x4*)(P1 + (size_t)trow * NREST + C_O + col);
                const f32x4 g0 = *(const f32x4*)(p.ml_norm_g + col), g1 = *(const f32x4*)(p.ml_norm_g + col + 4);
                const f32x4 h0 = *(const f32x4*)(Hs + it * 260 + c8), h1 = *(const f32x4*)(Hs + it * 260 + c8 + 4);
                u32x4 w;
                w.x = pk2(h0[0] * g0[0] * sigmoidf_(blo(ow.x)), h0[1] * g0[1] * sigmoidf_(bhi(ow.x))); w.y = pk2(h0[2] * g0[2] * sigmoidf_(blo(ow.y)), h0[3] * g0[3] * sigmoidf_(bhi(ow.y)));
                w.z = pk2(h1[0] * g1[0] * sigmoidf_(blo(ow.z)), h1[1] * g1[1] * sigmoidf_(bhi(ow.z))); w.w = pk2(h1[2] * g1[2] * sigmoidf_(blo(ow.w)), h1[3] * g1[3] * sigmoidf_(bhi(ow.w)));
                *(u32x4*)(HML + (size_t)trow * D + col) = w;
            }
        }
    }
    __syncthreads();
}

struct cf { float x, y; };
__device__ __forceinline__ cf cmul(cf a, cf b) { return cf{a.x * b.x - a.y * b.y, a.x * b.y + a.y * b.x}; }
__device__ __forceinline__ cf cmulc(cf a, cf b) { return cf{a.x * b.x + a.y * b.y, a.y * b.x - a.x * b.y}; }
constexpr int FM = 8192;
__device__ __forceinline__ int fphys(int i) { return i + (i >> 3); }
constexpr int FARR = (FM + FM / 8) * 8;
__device__ constexpr float c16(int n) { return n==0?1.f: n==1?0.92387953251f: n==2?0.70710678119f: n==3?0.38268343237f: n==4?0.f: n==5?-0.38268343237f: n==6?-0.70710678119f: -0.92387953251f; }
__device__ constexpr float s16(int n) { return n==0?0.f: n==1?0.38268343237f: n==2?0.70710678119f: n==3?0.92387953251f: n==4?1.f: n==5?0.92387953251f: n==6?0.70710678119f: 0.38268343237f; }
typedef float c2 __attribute__((ext_vector_type(2)));
__device__ __forceinline__ c2 bx(c2 a) { return (c2){a.x, a.x}; }
__device__ __forceinline__ c2 by(c2 a) { return (c2){a.y, a.y}; }
template <int A, bool INV>
__device__ __forceinline__ void fft_pass(cf* Xc, int s, int tid) {
    c2* X = (c2*)Xc;
    constexpr int R = 1 << A;
    const int hl = FM >> (s + A);
    for (int sub = tid; sub < FM / R; sub += NT) {
        const int lo = sub & (hl - 1), hi = sub / hl;
        const int base = hi * (hl * R) + lo;
        c2 v[R];
        const int pbase = fphys(base);
#define FOFF(m_) (hl >= 8 ? (m_) * (hl + (hl >> 3)) : ((m_) * hl + (((m_) * hl) >> 3)))
#pragma unroll
        for (int m = 0; m < R; ++m) v[m] = X[pbase + FOFF(m)];
        float sn, cs;
        int lo_ = lo; asm volatile("" : "+v"(lo_));
        __sincosf(-6.283185307179586f * (float)lo_ / (float)(hl * R), &sn, &cs);
        c2 w[A];
        w[0] = (c2){cs, sn};
#pragma unroll
        for (int t = 1; t < A; ++t) { const c2 q = w[t - 1]; w[t] = bx(q) * q + by(q) * (c2){-q.y, q.x}; }
#pragma unroll
        for (int tt = 0; tt < A; ++tt) {
            const int t = INV ? A - 1 - tt : tt;
            const int hm = 1 << (A - 1 - t);
            c2 ta[R / 2], tb[R / 2];
#pragma unroll
            for (int jm = 0; jm < R / 2; ++jm) {
                if (jm >= hm) continue;
                const int n16 = (jm << t) * (16 / R);
                const float c = c16(n16), sg = s16(n16);
                const c2 q = w[t];
                const c2 tw = (c2){c * q.x + sg * q.y, c * q.y - sg * q.x};
                if (!INV) { ta[jm] = tw; tb[jm] = (c2){-tw.y, tw.x}; }
                else { ta[jm] = (c2){tw.x, -tw.y}; tb[jm] = (c2){tw.y, tw.x}; }
            }
#pragma unroll
            for (int m = 0; m < R; ++m) {
                if (m & hm) continue;
                const int jm = m & (hm - 1);
                const c2 a = v[m], b = v[m + hm];
                if (!INV) { const c2 d = a - b; v[m] = a + b; v[m + hm] = bx(d) * ta[jm] + by(d) * tb[jm]; }
                else { const c2 e = bx(b) * ta[jm] + by(b) * tb[jm]; v[m] = a + e; v[m + hm] = a - e; }
            }
        }
#pragma unroll
        for (int m = 0; m < R; ++m) X[pbase + FOFF(m)] = v[m];
#undef FOFF
    }
}
__device__ __forceinline__ int brev13(int k) { return (int)(__brev((unsigned)k) >> 19); }
__device__ __forceinline__ void spec_mul(cf* Z, const cf* G, int tid) {
    for (int idx = tid; idx <= FM / 2; idx += NT) {
        const int p = idx < FM / 2 ? 2 * idx : 1;
        const int k = brev13(p), k2 = (FM - k) & (FM - 1);
        const int pa = fphys(p), pb = fphys(brev13(k2));
        const cf a = Z[pa], b = Z[pb], c = G[pa], d = G[pb];
        const cf Ex{0.5f * (a.x + b.x), 0.5f * (a.y - b.y)};
        const cf tx{0.5f * (a.x - b.x), 0.5f * (a.y + b.y)};
        const cf Ox{tx.y, -tx.x};
        const cf Eg{0.5f * (c.x + d.x), 0.5f * (c.y - d.y)};
        const cf tg{0.5f * (c.x - d.x), 0.5f * (c.y + d.y)};
        const cf Og{tg.y, -tg.x};
        float sn, cs;
        __sincosf(-6.283185307179586f * (float)k / (float)FM, &sn, &cs);
        const cf oo = cmul(cmul(Ox, Og), cf{cs, sn});
        const cf ee = cmul(Ex, Eg);
        const cf Ey{ee.x + oo.x, ee.y + oo.y};
        const cf eo = cmul(Ex, Og), oe = cmul(Ox, Eg);
        const cf Oy{eo.x + oe.x, eo.y + oe.y};
        const float sc = 1.0f / (float)FM;
        Z[pa] = cf{(Ey.x - Oy.y) * sc, (Ey.y + Oy.x) * sc};
        if (pb != pa) Z[pb] = cf{(Ey.x + Oy.y) * sc, (-Ey.y + Oy.x) * sc};
    }
}
#define GFI(j) (2 * fphys((j) >> 1) + ((j) & 1))
__device__ __forceinline__ void hy_filter(const Params& p, int c, int o, float* Gf) {
    const int tid = otid();
    const bf16_t* FW = (const bf16_t*)(p.ws + WS_FILT) + (size_t)(o * 2048 + c) * 8192;
    const bf16_t* BW = (const bf16_t*)(p.ws + WS_FILT) + (size_t)(4096 + o * 2048 + c) * 8192;
    const float bias = p.hy_bias[o * 2048 + c];
#pragma unroll
    for (int i = 0; i < 2; ++i) {
        const int t8 = (tid + NT * i) * 8;
        const u32x4 f = *(const u32x4*)(FW + t8), b = *(const u32x4*)(BW + t8);
        const float fv[8] = {blo(f.x), bhi(f.x), blo(f.y), bhi(f.y), blo(f.z), bhi(f.z), blo(f.w), bhi(f.w)};
        const float bv[8] = {blo(b.x), bhi(b.x), blo(b.y), bhi(b.y), blo(b.z), bhi(b.z), blo(b.w), bhi(b.w)};
#pragma unroll
        for (int e = 0; e < 8; ++e) {
            const int t = t8 + e;
            if (t == 0) { Gf[GFI(0)] = fv[0] + bv[0] + bias; Gf[GFI(8192)] = 0.f; }
            else { Gf[GFI(t)] = fv[e]; Gf[GFI(16384 - t)] = bv[e]; }
        }
    }
}
__device__ __forceinline__ void hy_short8(const bf16_t* row, int t8, float w0, float w1, float w2, float* out) {
    const u32x4 w = *(const u32x4*)(row + t8);
    const float prev = t8 > 0 ? bf2f(row[t8 - 1]) : 0.f, next = t8 + 8 < L ? bf2f(row[t8 + 8]) : 0.f;
    const float r[10] = {prev, blo(w.x), bhi(w.x), blo(w.y), bhi(w.y), blo(w.z), bhi(w.z), blo(w.w), bhi(w.w), next};
#pragma unroll
    for (int e = 0; e < 8; ++e) out[e] = r[e] * w0 + r[e + 1] * w1 + r[e + 2] * w2;
}
__device__ __forceinline__ void hy_tw4(int n0, c2* w) {
    float sn, cs; __sincosf(-6.283185307179586f * (float)n0 / (float)FM, &sn, &cs);
    w[0] = (c2){cs, sn};
    const c2 w1 = {0.99999970586f, -7.6699031874e-4f};
#pragma unroll
    for (int j = 1; j < 4; ++j) { const c2 q = w[j - 1]; w[j] = (c2){q.x * w1.x - q.y * w1.y, q.x * w1.y + q.y * w1.x}; }
}
__device__ __forceinline__ void p8_hyena(const Params& p, unsigned char* lds) {
    const int tid = otid();
    cf* Z = (cf*)lds; cf* G = (cf*)(lds + FARR);
    c2* Z2 = (c2*)lds;
    const bf16_t* HYT = (const bf16_t*)(p.ws + WS_HYT);
    bf16_t* HYOT = (bf16_t*)(p.ws + WS_HYOT);
    for (int c = blockIdx.x; c < 2048; c += gridDim.x) {
        const bf16_t* rx1 = HYT + (size_t)c * L; const bf16_t* rx2 = HYT + (size_t)(2048 + c) * L; const bf16_t* rv = HYT + (size_t)(4096 + c) * L;
        const float* cw = p.hy_conv_w;
        const float a0 = cw[c], a1 = cw[6144 + c], a2 = cw[2 * 6144 + c];
        const float b0 = cw[2048 + c], b1 = cw[6144 + 2048 + c], b2 = cw[2 * 6144 + 2048 + c];
        const float v0 = cw[4096 + c], v1 = cw[6144 + 4096 + c], v2 = cw[2 * 6144 + 4096 + c];
        __syncthreads();
#pragma unroll
        for (int i = 0; i < 2; ++i) {
            const int t8 = (tid + NT * i) * 8, n0 = t8 >> 1;
            float z[8]; hy_short8(rv, t8, v0, v1, v2, z);
            c2 w[4]; hy_tw4(n0, w);
#pragma unroll
            for (int j = 0; j < 4; ++j) { const c2 a = {z[2 * j], z[2 * j + 1]}; Z2[fphys(n0 + j)] = a; Z2[fphys(n0 + j + FM / 2)] = (c2){a.x * w[j].x - a.y * w[j].y, a.x * w[j].y + a.y * w[j].x}; }
        }
        for (int o = 0; o < 2; ++o) {
            hy_filter(p, c, o, (float*)G);
            __syncthreads();
            fft_pass<4, false>(Z, 1, tid); asm volatile("" ::: "memory"); __builtin_amdgcn_sched_barrier(0); fft_pass<4, false>(G, 0, tid); __syncthreads();
            fft_pass<4, false>(Z, 5, tid); asm volatile("" ::: "memory"); __builtin_amdgcn_sched_barrier(0); fft_pass<3, false>(G, 4, tid); __syncthreads();
            fft_pass<4, false>(Z, 9, tid); asm volatile("" ::: "memory"); __builtin_amdgcn_sched_barrier(0); fft_pass<3, false>(G, 7, tid); __syncthreads();
            fft_pass<3, false>(G, 10, tid); __syncthreads();
            spec_mul(Z, G, tid); __syncthreads();
            fft_pass<4, true>(Z, 9, tid); __syncthreads();
            fft_pass<4, true>(Z, 5, tid); __syncthreads();
            fft_pass<4, true>(Z, 1, tid); __syncthreads();
#pragma unroll
            for (int i = 0; i < 2; ++i) {
                const int t8 = (tid + NT * i) * 8, n0 = t8 >> 1;
                float x[8];
                if (o == 0) hy_short8(rx1, t8, a0, a1, a2, x); else hy_short8(rx2, t8, b0, b1, b2, x);
                c2 w[4]; hy_tw4(n0, w);
                unsigned ww[4];
#pragma unroll
                for (int j = 0; j < 4; ++j) {
                    const c2 lo = Z2[fphys(n0 + j)], hi = Z2[fphys(n0 + j + FM / 2)];
                    const c2 y = {lo.x + hi.x * w[j].x + hi.y * w[j].y, lo.y + hi.y * w[j].x - hi.x * w[j].y};
                    const c2 r = {y.x * x[2 * j], y.y * x[2 * j + 1]};
                    if (o == 0) { Z2[fphys(n0 + j)] = r; Z2[fphys(n0 + j + FM / 2)] = (c2){r.x * w[j].x - r.y * w[j].y, r.x * w[j].y + r.y * w[j].x}; }
                    else ww[j] = pk2(r.x, r.y);
                }
                if (o == 1) { u32x4 wv4; wv4.x = ww[0]; wv4.y = ww[1]; wv4.z = ww[2]; wv4.w = ww[3]; *(u32x4*)(HYOT + (size_t)c * L + t8) = wv4; }
            }
        }
    }
    __syncthreads();
}

__device__ __forceinline__ void p9_transpose(const Params& p, unsigned char* lds) {
    const int tid = otid();
    bf16_t* T = (bf16_t*)lds;
    const bf16_t* S = (const bf16_t*)(p.ws + WS_HYOT); bf16_t* O = (bf16_t*)(p.ws + WS_HYO);
    for (int tix = blockIdx.x; tix < 32 * 128; tix += gridDim.x) {
        const int ct = tix >> 7, tt = tix & 127;
        __syncthreads();
        { const int r = tid >> 3, c8 = tid & 7; const u32x4 w = *(const u32x4*)(S + (size_t)(ct * 64 + r) * L + tt * 64 + c8 * 8);
          unsigned* d = (unsigned*)(T + r * 66 + c8 * 8); d[0] = w.x; d[1] = w.y; d[2] = w.z; d[3] = w.w; }
        __syncthreads();
        { const int t = tid >> 3, c8 = tid & 7; u32x4 w;
          w.x = (unsigned)T[(c8 * 8 + 0) * 66 + t] | ((unsigned)T[(c8 * 8 + 1) * 66 + t] << 16); w.y = (unsigned)T[(c8 * 8 + 2) * 66 + t] | ((unsigned)T[(c8 * 8 + 3) * 66 + t] << 16);
          w.z = (unsigned)T[(c8 * 8 + 4) * 66 + t] | ((unsigned)T[(c8 * 8 + 5) * 66 + t] << 16); w.w = (unsigned)T[(c8 * 8 + 6) * 66 + t] | ((unsigned)T[(c8 * 8 + 7) * 66 + t] << 16);
          *(u32x4*)(O + (size_t)(tt * 64 + t) * D + ct * 64 + c8 * 8) = w; }
    }
    __syncthreads();
}
__device__ __forceinline__ void p12_tables(const Params& p) {
    const int tid = otid(), lane = tid & 63, wv = tid >> 6;
    for (int row = blockIdx.x * 8 + wv; row < 2 * 16384; row += gridDim.x * 8) {
        const bool second = row >= 16384; const int r = second ? row - 16384 : row;
        const float* src = (second ? p.peer_v : p.peer_u) + (size_t)r * D;
        f32x4 v[2][4]; float am = 0.f;
#pragma unroll
        for (int i = 0; i < 2; ++i)
#pragma unroll
            for (int j = 0; j < 4; ++j) { v[i][j] = *(const f32x4*)(src + 16 * (lane + 64 * i) + 4 * j);
                am = fmaxf(am, fmaxf(fmaxf(fabsf(v[i][j][0]), fabsf(v[i][j][1])), fmaxf(fabsf(v[i][j][2]), fabsf(v[i][j][3])))); }
#pragma unroll
        for (int o = 32; o >= 1; o >>= 1) am = fmaxf(am, __shfl_xor(am, o));
        const float inv = am > 0.f ? 440.0f / am : 0.f;
        unsigned char* dst = p.ws + (second ? WS_PV : WS_PU) + (size_t)r * D;
#pragma unroll
        for (int i = 0; i < 2; ++i) {
            u32x4 w;
#pragma unroll
            for (int j = 0; j < 4; ++j) { int x = 0;
                x = __builtin_amdgcn_cvt_pk_fp8_f32(v[i][j][0] * inv, v[i][j][1] * inv, x, false);
                x = __builtin_amdgcn_cvt_pk_fp8_f32(v[i][j][2] * inv, v[i][j][3] * inv, x, true);
                w[j] = (unsigned)x; }
            *(u32x4*)(dst + 16 * (lane + 64 * i)) = w;
        }
        if (lane == 0) ((float*)(p.ws + (second ? WS_PSV : WS_PSU)))[r] = am > 0.f ? am / 440.0f : 0.f;
    }
    for (int i = blockIdx.x * NT + tid; i < 8 * 2 * 128 * 128 / 2; i += gridDim.x * NT) ((unsigned*)(p.ws + WS_KEYB))[i] = pk2(p.peer_keys[2 * i], p.peer_keys[2 * i + 1]);
}
typedef float f32x2 __attribute__((ext_vector_type(2)));
#define CVT2(w_, hi_) __builtin_amdgcn_cvt_pk_f32_fp8((int)(w_), (hi_))
__device__ __forceinline__ f32x2 dot16_fp8(u32x4 w8, const f32x2* tv, f32x2 s) {
    s += CVT2(w8.x, false) * tv[0]; s += CVT2(w8.x, true) * tv[1]; s += CVT2(w8.y, false) * tv[2]; s += CVT2(w8.y, true) * tv[3];
    s += CVT2(w8.z, false) * tv[4]; s += CVT2(w8.z, true) * tv[5]; s += CVT2(w8.w, false) * tv[6]; s += CVT2(w8.w, true) * tv[7];
    return s;
}
__device__ __forceinline__ void axpy16_fp8(u32x4 w8, f32x2 act2, f32x2* ao) {
    ao[0] += act2 * CVT2(w8.x, false); ao[1] += act2 * CVT2(w8.x, true); ao[2] += act2 * CVT2(w8.y, false); ao[3] += act2 * CVT2(w8.y, true);
    ao[4] += act2 * CVT2(w8.z, false); ao[5] += act2 * CVT2(w8.z, true); ao[6] += act2 * CVT2(w8.w, false); ao[7] += act2 * CVT2(w8.w, true);
}
__device__ __forceinline__ f32x2 gelu_pk(f32x2 v) {
    const f32x2 av = __builtin_elementwise_abs(v), d = av * 0.2316418882f + 1.0f;
    f32x2 t; t.x = __builtin_amdgcn_rcpf(d.x); t.y = __builtin_amdgcn_rcpf(d.y);
    f32x2 q = t * 0.5307027145f + (-0.7265760135f); q = q * t + 0.7107068705f; q = q * t + (-0.142248368f); q = q * t + 0.127414796f; q = q * t;
    const f32x2 s = (v * v) * (-0.72134752044f);
    f32x2 e; e.x = __builtin_amdgcn_exp2f(s.x); e.y = __builtin_amdgcn_exp2f(s.y);
    const f32x2 m = v * (q * e), r = v - m;
    f32x2 o; o.x = v.x < 0.f ? m.x : r.x; o.y = v.y < 0.f ? m.y : r.y; return o;
}
struct ExGroup { u32x4 uw[GX][2], vw[GX][2]; float gg[GX], su[GX], sv[GX]; };

__device__ __forceinline__ void wave_argmax(float& bv, int& bi) {
#pragma unroll
    for (int o = 32; o >= 1; o >>= 1) {
        const float ov = __shfl_xor(bv, o); const int oi = __shfl_xor(bi, o);
        if (ov > bv || (ov == bv && oi < bi)) { bv = ov; bi = oi; }
    }
}
__device__ __forceinline__ void top16_128(float v0, float v1, int lane, float& outS, int& outI) {
    outS = 0.f; outI = 0;
#pragma unroll 1
    for (int it = 0; it < 16; ++it) {
        const bool u1 = v1 > v0; float bv = u1 ? v1 : v0; int bi = u1 ? lane + 64 : lane;
        wave_argmax(bv, bi);
        if (lane == it) { outS = bv; outI = bi; }
        if (bi == lane) v0 = -3.0e38f; else if (bi == lane + 64) v1 = -3.0e38f;
    }
}
__device__ __forceinline__ void p14_peer(const Params& p, unsigned char* lds) {
    const int tid = otid(), lane = tid & 63, wv = tid >> 6, fr = lane & 15, fq = lane >> 4;
    const bf16_t* QP = (const bf16_t*)(p.ws + WS_QP);
    const bf16_t* VL = (const bf16_t*)(p.ws + WS_VL);
    const float* HLAT = (const float*)(p.ws + WS_HLAT);
    const float* MOD = (const float*)(p.ws + WS_MOD);
    float* Sc = (float*)lds;
    int* eS = (int*)(lds + 2 * 32 * 2 * 132 * 4);
    float* gS = (float*)(eS + 32 * 128);
    float* tS = gS + 32 * 128;
    int* tI = (int*)(tS + 32 * 2 * 16);
    float* cSw = (float*)(tI + 32 * 2 * 16);
    float* lSw = cSw + 8 * 64;
    const bf16_t* KEYB = (const bf16_t*)(p.ws + WS_KEYB);
    int ca = 0, cb = 0;
    { int rem = lane; for (ca = 0; ca < 16; ++ca) { const int cnt = 16 / (ca + 1); if (rem < cnt) break; rem -= cnt; } cb = rem; if (lane >= 50) { ca = 0; cb = 0; } }
    for (int u = blockIdx.x; u < L / 32; u += gridDim.x) {
        const int t0 = u * 32;
        const int rt = wv & 1;
        int fq8o = fq * 8; asm volatile("" : "+v"(fq8o));
        bf16x8 af[2][4];
#define SC_LOAD(hh_) do { _Pragma("unroll") for (int pp = 0; pp < 2; ++pp) _Pragma("unroll") for (int kk = 0; kk < 4; ++kk) \
            af[pp][kk] = *(const bf16x8*)(QP + (size_t)(t0 + rt * 16 + fr) * D + (hh_) * 256 + pp * 128 + kk * 32 + fq8o); } while (0)
        SC_LOAD(0);
#pragma unroll 1
        for (int h = 0; h < 8; ++h) {
            float* ScH = Sc + (h & 1) * (32 * 2 * 132);
            {
                bf16x8 bfr[2][2][4];
#pragma unroll
                for (int pp = 0; pp < 2; ++pp)
#pragma unroll
                    for (int kk = 0; kk < 4; ++kk)
#pragma unroll
                        for (int t2 = 0; t2 < 2; ++t2) bfr[pp][t2][kk] = *(const bf16x8*)(KEYB + ((size_t)(h * 2 + pp) * 128 + ((wv >> 1) * 2 + t2) * 16 + fr) * 128 + kk * 32 + fq8o);
#pragma unroll
                for (int pp = 0; pp < 2; ++pp)
#pragma unroll
                    for (int t2 = 0; t2 < 2; ++t2) {
                        const int kt = (wv >> 1) * 2 + t2;
                        f32x4 acc = {0.f, 0.f, 0.f, 0.f};
#pragma unroll
                        for (int kk = 0; kk < 4; ++kk) acc = mfma16(af[pp][kk], bfr[pp][t2][kk], acc);
#pragma unroll
                        for (int j = 0; j < 4; ++j) ScH[((rt * 16 + fq * 4 + j) * 2 + pp) * 132 + kt * 16 + fr] = __uint_as_float((__float_as_uint(acc[j]) & ~127u) | (unsigned)(127 - (kt * 16 + fr)));
                    }
                if (h + 1 < 8) SC_LOAD(h + 1);
            }
            __syncthreads();
            {
                unsigned k0[8], k1[8], T[8];
#pragma unroll
                for (int q = 0; q < 8; ++q) {
                    const float* row = ScH + ((wv * 4 + (q >> 1)) * 2 + (q & 1)) * 132;
                    const unsigned b0 = __float_as_uint(row[lane]), b1 = __float_as_uint(row[lane + 64]);
                    k0[q] = b0 ^ ((b0 >> 31) ? 0xFFFFFFFFu : 0x80000000u); k1[q] = b1 ^ ((b1 >> 31) ? 0xFFFFFFFFu : 0x80000000u);
                    T[q] = 0u;
                }
#pragma unroll 1
                for (int bit = 31; bit >= 7; --bit) {
#pragma unroll
                    for (int q = 0; q < 8; ++q) {
                        const unsigned cand = T[q] | (1u << bit);
                        const int cnt = __popcll(__ballot(k0[q] >= cand)) + __popcll(__ballot(k1[q] >= cand));
                        T[q] = cnt >= 16 ? cand : T[q];
                    }
                }
#pragma unroll
                for (int q = 0; q < 8; ++q) {
                    const int tk = wv * 4 + (q >> 1), pp = q & 1;
                    const float* row = ScH + (tk * 2 + pp) * 132;
                    const bool s0 = k0[q] >= T[q], s1 = k1[q] >= T[q];
                    const unsigned long long m0 = __ballot(s0), m1 = __ballot(s1);
                    const int p0 = __builtin_amdgcn_mbcnt_hi((unsigned)(m0 >> 32), __builtin_amdgcn_mbcnt_lo((unsigned)m0, 0u));
                    const int p1 = __popcll(m0) + __builtin_amdgcn_mbcnt_hi((unsigned)(m1 >> 32), __builtin_amdgcn_mbcnt_lo((unsigned)m1, 0u));
                    float* lS = lSw + (wv * 8 + q) * 32; int* lI = (int*)(lS + 16);
                    if (s0 && p0 < 16) { lS[p0] = row[lane]; lI[p0] = lane; }
                    if (s1 && p1 < 16) { lS[p1] = row[lane + 64]; lI[p1] = lane + 64; }
                }
                __builtin_amdgcn_wave_barrier();
#pragma unroll
                for (int rd = 0; rd < 2; ++rd) {
                    const int q = rd * 4 + (lane >> 4), j = lane & 15, tk = wv * 4 + (q >> 1), pp = q & 1;
                    const float* lS = lSw + (wv * 8 + q) * 32; const int* lI = (const int*)(lS + 16);
                    const float my = lS[j]; const int mi = lI[j];
                    int rk = 0;
#pragma unroll
                    for (int j4 = 0; j4 < 4; ++j4) { const f32x4 x = *(const f32x4*)(lS + j4 * 4);
#pragma unroll
                        for (int e = 0; e < 4; ++e) rk += (x[e] > my) ? 1 : 0; }
                    tS[(tk * 2 + pp) * 16 + rk] = my; tI[(tk * 2 + pp) * 16 + rk] = mi;
                }
            }
            __builtin_amdgcn_wave_barrier();
            {
                float cval[4]; unsigned ck[4], T[4];
#pragma unroll
                for (int q = 0; q < 4; ++q) {
                    const int tk = wv * 4 + q;
                    cval[q] = tS[(tk * 2) * 16 + ca] + tS[(tk * 2 + 1) * 16 + cb];
                    const unsigned bb = __float_as_uint(cval[q]);
                    ck[q] = lane < 50 ? (bb ^ ((bb >> 31) ? 0xFFFFFFFFu : 0x80000000u)) : 0u;
                    T[q] = 0u;
                }
#pragma unroll 1
                for (int bit = 31; bit >= 7; --bit) {
#pragma unroll
                    for (int q = 0; q < 4; ++q) {
                        const unsigned cand = T[q] | (1u << bit);
                        const int cnt = __popcll(__ballot(ck[q] >= cand));
                        T[q] = cnt >= 16 ? cand : T[q];
                    }
                }
                float ex[4]; int slot[4]; bool okw[4];
#pragma unroll
                for (int q = 0; q < 4; ++q) {
                    const int tk = wv * 4 + q;
                    const bool win = ck[q] >= T[q] && lane < 50;
                    const unsigned long long m = __ballot(win);
                    slot[q] = __builtin_amdgcn_mbcnt_hi((unsigned)(m >> 32), __builtin_amdgcn_mbcnt_lo((unsigned)m, 0u));
                    okw[q] = win && slot[q] < 16;
                    const float mx = tS[(tk * 2) * 16] + tS[(tk * 2 + 1) * 16];
                    ex[q] = okw[q] ? __expf(cval[q] - mx) : 0.f;
                }
                float sm[4];
#pragma unroll
                for (int q = 0; q < 4; ++q) sm[q] = ex[q];
#pragma unroll
                for (int o = 32; o >= 1; o >>= 1) {
#pragma unroll
                    for (int q = 0; q < 4; ++q) sm[q] += __shfl_xor(sm[q], o);
                }
#pragma unroll
                for (int q = 0; q < 4; ++q) {
                    const int tk = wv * 4 + q;
                    if (okw[q]) { eS[tk * 128 + h * 16 + slot[q]] = tI[(tk * 2) * 16 + ca] * 128 + tI[(tk * 2 + 1) * 16 + cb]; gS[tk * 128 + h * 16 + slot[q]] = ex[q] / sm[q]; }
                }
            }
        }
        __syncthreads();
        const unsigned char* PU8 = p.ws + WS_PU; const unsigned char* PV8 = p.ws + WS_PV;
        const float* PSU = (const float*)(p.ws + WS_PSU); const float* PSV = (const float*)(p.ws + WS_PSV);
#pragma unroll 1
#define GQ 4
        for (int q = 0; q < 4; ++q) {
            const int tk = wv * 4 + q, t = t0 + tk;
            f32x2 tv[16];
#pragma unroll
            for (int i = 0; i < 2; ++i)
#pragma unroll
                for (int hh = 0; hh < 2; ++hh) { const u32x4 w = *(const u32x4*)(VL + (size_t)t * D + 16 * (lane + 64 * i) + 8 * hh);
                    tv[i * 8 + hh * 4 + 0] = (f32x2){blo(w.x), bhi(w.x)}; tv[i * 8 + hh * 4 + 1] = (f32x2){blo(w.y), bhi(w.y)}; tv[i * 8 + hh * 4 + 2] = (f32x2){blo(w.z), bhi(w.z)}; tv[i * 8 + hh * 4 + 3] = (f32x2){blo(w.w), bhi(w.w)}; }
            struct UG { u32x4 uw[GQ][2]; float su[GQ], sv[GQ]; };
#define EXU_LOAD(G_, k0_) do { _Pragma("unroll") for (int x = 0; x < GQ; ++x) { const int e = eS[tk * 128 + (k0_) + x]; G_.su[x] = PSU[e]; G_.sv[x] = PSV[e]; \
        _Pragma("unroll") for (int i = 0; i < 2; ++i) G_.uw[x][i] = *(const u32x4*)(PU8 + (size_t)e * D + 16 * (lane + 64 * i)); } } while (0)
#define EXU_COMPUTE(G_, k0_) do { float d[GQ]; \
        _Pragma("unroll") for (int x = 0; x < GQ; ++x) { f32x2 s2 = {0.f, 0.f}; s2 = dot16_fp8(G_.uw[x][0], tv, s2); s2 = dot16_fp8(G_.uw[x][1], tv + 8, s2); d[x] = s2.x + s2.y; } \
        _Pragma("unroll") for (int o = 32; o >= 1; o >>= 1) { _Pragma("unroll") for (int x = 0; x < GQ; ++x) d[x] += __shfl_xor(d[x], o); } \
        const f32x2 g01 = gelu_pk((f32x2){d[0] * G_.su[0], d[1] * G_.su[1]}), g23 = gelu_pk((f32x2){d[2] * G_.su[2], d[3] * G_.su[3]}); \
        const float av = lane == 0 ? g01.x * G_.sv[0] : lane == 1 ? g01.y * G_.sv[1] : lane == 2 ? g23.x * G_.sv[2] : g23.y * G_.sv[3]; \
        if (lane < GQ) gS[tk * 128 + (k0_) + lane] *= av; } while (0)
            UG ga, gb;
            EXU_LOAD(ga, 0);
#pragma unroll 1
            for (int k0 = 0; k0 < 128; k0 += 2 * GQ) {
                EXU_LOAD(gb, k0 + GQ);
                EXU_COMPUTE(ga, k0);
                if (k0 + 2 * GQ < 128) EXU_LOAD(ga, k0 + 2 * GQ);
                EXU_COMPUTE(gb, k0 + GQ);
            }
        }
        __builtin_amdgcn_wave_barrier();
        for (int q = 0; q < 4; ++q) {
            const int tk = wv * 4 + q, t = t0 + tk;
            f32x2 ao[16];
#pragma unroll
            for (int i = 0; i < 16; ++i) ao[i] = (f32x2){0.f, 0.f};
            struct VG { u32x4 vw[GQ][2]; float act[GQ]; };
#define EXV_LOAD(G_, k0_) do { _Pragma("unroll") for (int x = 0; x < GQ; ++x) { const int e = eS[tk * 128 + (k0_) + x]; G_.act[x] = gS[tk * 128 + (k0_) + x]; \
        _Pragma("unroll") for (int i = 0; i < 2; ++i) G_.vw[x][i] = *(const u32x4*)(PV8 + (size_t)e * D + 16 * (lane + 64 * i)); } } while (0)
#define EXV_COMPUTE(G_) do { _Pragma("unroll") for (int x = 0; x < GQ; ++x) { const f32x2 act2 = {G_.act[x], G_.act[x]}; axpy16_fp8(G_.vw[x][0], act2, ao); axpy16_fp8(G_.vw[x][1], act2, ao + 8); } } while (0)
            VG ga, gb;
            EXV_LOAD(ga, 0);
#pragma unroll 1
            for (int k0 = 0; k0 < 128; k0 += 2 * GQ) {
                EXV_LOAD(gb, k0 + GQ);
                EXV_COMPUTE(ga);
                if (k0 + 2 * GQ < 128) EXV_LOAD(ga, k0 + 2 * GQ);
                EXV_COMPUTE(gb);
            }
            int lane16 = 16 * lane; asm volatile("" : "+v"(lane16));
            float ss = 0.f;
#pragma unroll
            for (int i = 0; i < 2; ++i)
#pragma unroll
                for (int j = 0; j < 4; ++j) {
                    const int c = lane16 + 1024 * i + 4 * j;
                    const f32x4 hv = *(const f32x4*)(HLAT + (size_t)t * D + c), g2 = *(const f32x4*)(MOD + 5 * D + c);
                    f32x2 v0 = ao[i * 8 + j * 2], v1 = ao[i * 8 + j * 2 + 1];
                    v0.x = hv[0] + g2[0] * v0.x; v0.y = hv[1] + g2[1] * v0.y; v1.x = hv[2] + g2[2] * v1.x; v1.y = hv[3] + g2[3] * v1.y;
                    ao[i * 8 + j * 2] = v0; ao[i * 8 + j * 2 + 1] = v1; ss += v0.x * v0.x + v0.y * v0.y + v1.x * v1.x + v1.y * v1.y;
                }
            ss = wave_sum(ss);
            const float rinv = rsqrtf(ss * (1.0f / D) + EPS);
#pragma unroll
            for (int i = 0; i < 2; ++i)
#pragma unroll
                for (int j = 0; j < 4; ++j) {
                    const int c = lane16 + 1024 * i + 4 * j;
                    const f32x4 fg = *(const f32x4*)(p.final_g + c);
                    const f32x2 v0 = ao[i * 8 + j * 2], v1 = ao[i * 8 + j * 2 + 1];
                    f32x4 o; o[0] = v0.x * rinv * fg[0]; o[1] = v0.y * rinv * fg[1]; o[2] = v1.x * rinv * fg[2]; o[3] = v1.y * rinv * fg[3];
                    *(f32x4*)(p.out + (size_t)t * D + c) = o;
                }
        }
    }
    __syncthreads();
}

__global__ void __launch_bounds__(NT, 2) fwd_megakernel(Params p) {
    extern __shared__ __attribute__((aligned(16))) unsigned char lds[];
    cg::grid_group grid = cg::this_grid();
    PG8_LAS unsigned char* ldsg = (PG8_LAS unsigned char*)lds;
    const int G = gridDim.x, bx = blockIdx.x;
    volatile LAS unsigned* xst = (volatile LAS unsigned*)((LAS unsigned char*)lds + LDS_MAIN);
    if (threadIdx.x < 4) xst[threadIdx.x] = 0u;
    __syncthreads();
    XcdBarrier bar = xcd_barrier_post((unsigned*)(p.ws + WS_BAR), xst);
#define W16(off) ((bf16_t*)(p.ws + (off)))
#define PHASE(k, body) do { body; if ((REPEAT_MASK >> (k)) & 1) { xcd_barrier(bar); body; } } while (0)
    PHASE(0, p0_gemv_hdn(p, lds));
    if (p.ph_lo < 0) grid.sync();
    xcd_barrier(bar);
    PHASE(1, ({ p1_filters(p); p1_weights(p, lds); }));
    xcd_barrier(bar);
    PHASE(2, p_rownorm<0>(p));
    xcd_barrier(bar);
    PHASE(3, ({ p3_side_tasks(p, lds);
                { pg8::Gemm g{W16(WS_WHY), W16(WS_U), 6144, L, D}; pg8::StaticOrder S; S.init(6144, L, G, bx); pg8::EpiBf16 E{W16(WS_HYT), L}; pg8::gemm_phase<pg8::EpiBf16, pg8::StaticOrder>(ldsg, g, S, E); }
                  { pg8::Gemm g{W16(WS_U), W16(WS_WREST), L, C_GT, D}; pg8::StaticOrder S; S.init(L, C_GT, G, bx); pg8::EpiBf16 E{W16(WS_P1), NREST}; pg8::gemm_phase<pg8::EpiBf16, pg8::StaticOrder>(ldsg, g, S, E); } }));
    xcd_barrier(bar);
    PHASE(8, p8_hyena(p, lds));
    PHASE(4, p4_conv_gates(p, lds));
    xcd_barrier(bar);
    PHASE(5, p5_local_states(p, lds));
    xcd_barrier(bar);
    PHASE(6, p6_scan(p));
    xcd_barrier(bar);
    PHASE(7, ({ if (bx & 1) p12_tables(p); p7_mlstm_out(p, lds); if (!(bx & 1)) p12_tables(p); }));
    PHASE(9, p9_transpose(p, lds));
    xcd_barrier(bar);
    PHASE(10, ({ { pg8::Gemm g{W16(WS_HML), W16(WS_WPM), L, D, D}; pg8::StaticOrder S; S.init(L, D, G, bx); pg8::EpiGate1 E{(float*)(p.ws + WS_Y1), D, W16(WS_P1) + C_BGM, NREST}; pg8::gemm_phase<pg8::EpiGate1, pg8::StaticOrder>(ldsg, g, S, E); }
                   { pg8::Gemm g{W16(WS_HYO), W16(WS_WPH), L, D, D}; pg8::StaticOrder S; S.init(L, D, G, bx); pg8::EpiGate2 E{(const float*)(p.ws + WS_Y1), W16(WS_Y), D, W16(WS_P1) + C_BGH, NREST}; pg8::gemm_phase<pg8::EpiGate2, pg8::StaticOrder>(ldsg, g, S, E); } }));
    xcd_barrier(bar);
    PHASE(11, ({ pg8::Gemm g{W16(WS_Y), W16(WS_WO), L, D, D}; pg8::StaticOrder S; S.init(L, D, G, bx); pg8::EpiRes E{p.x, (float*)(p.ws + WS_HLAT), D, (const float*)(p.ws + WS_MOD) + 2 * D}; pg8::gemm_phase<pg8::EpiRes, pg8::StaticOrder>(ldsg, g, S, E); }));
    xcd_barrier(bar);
    PHASE(12, p_rownorm<1>(p));
    xcd_barrier(bar);
    PHASE(13, ({ pg8::Gemm g{W16(WS_VL), W16(WS_WQ), L, D, D}; pg8::StaticOrder S; S.init(L, D, G, bx); pg8::EpiBf16 E{W16(WS_QP), D}; pg8::gemm_phase<pg8::EpiBf16, pg8::StaticOrder>(ldsg, g, S, E); }));
    xcd_barrier(bar);
    PHASE(14, p14_peer(p, lds));
}
constexpr int NPHASE = 15;

extern "C" void kernel_launch(void* const* d_in, const int* in_sizes, int n_in, void* d_out, int out_size, void* d_ws, size_t ws_size, hipStream_t stream) {
    static int grid = 0;
    if (grid == 0) {
        if (n_in != 28 || ws_size < WS_END) { fprintf(stderr, "kernel_launch: n_in %d ws_size %zu (need %zu)\n", n_in, ws_size, (size_t)WS_END); grid = -1; return; }
        int dev = 0, cus = 0, per_cu = 0;
        hipGetDevice(&dev);
        hipDeviceGetAttribute(&cus, hipDeviceAttributeMultiprocessorCount, dev);
        if (hipFuncSetAttribute((const void*)fwd_megakernel, hipFuncAttributeMaxDynamicSharedMemorySize, LDS_BYTES) != hipSuccess) { fprintf(stderr, "kernel_launch: hipFuncSetAttribute failed\n"); grid = -1; return; }
        if (hipOccupancyMaxActiveBlocksPerMultiprocessor(&per_cu, (const void*)fwd_megakernel, NT, LDS_BYTES) != hipSuccess || per_cu < 1) { fprintf(stderr, "kernel_launch: occupancy query says %d\n", per_cu); (void)hipGetLastError(); grid = -1; return; }
        grid = cus;
    }
    if (grid < 0) return;
    Params p{};
    const float** pf = (const float**)&p;
    for (int i = 0; i < 28; ++i) pf[i] = (const float*)d_in[i];
    p.out = (float*)d_out; p.ws = (unsigned char*)d_ws;
    p.ph_lo = 0; p.ph_hi = NPHASE;
    if (hipMemsetAsync((char*)d_ws + WS_BAR, 0, (size_t)XCD_BAR_WORDS * 4, stream) != hipSuccess) { fprintf(stderr, "kernel_launch: memset failed\n"); return; }
    void* args[] = {&p};
    hipError_t e = hipLaunchCooperativeKernel((void*)fwd_megakernel, dim3(grid), dim3(NT), args, LDS_BYTES, stream);
    if (e != hipSuccess) fprintf(stderr, "cooperative launch failed: %s (grid %d)\n", hipGetErrorString(e), grid);
}
```
